# Optimizing an MI355X kernel written in HIP

```python
import math
import jax
import jax.numpy as jnp
from jax import lax
import numpy as np

D_MODEL = 1024
BATCH = 16
SEQ = 2048
DEPTH = 4

CTX_LEN = 256
GRID_W = 64
CONV_W = 4
EPS = 1e-6

LRU_WIDTH = D_MODEL
LRU_BLOCKS = 8
LRU_BW = LRU_WIDTH // LRU_BLOCKS
LRU_C = 8.0

GLA_HEADS = 4
GLA_DK = D_MODEL // 2
GLA_DV = D_MODEL
GLA_DKH = GLA_DK // GLA_HEADS
GLA_DVH = GLA_DV // GLA_HEADS
GLA_RANK = 16
GLA_TAU = 16.0
GLA_CHUNK = 64

SSD_INNER = 2 * D_MODEL
SSD_HEADDIM = 64
SSD_HEADS = SSD_INNER // SSD_HEADDIM
SSD_STATE = 128
SSD_GROUPS = 4
SSD_HPG = SSD_HEADS // SSD_GROUPS
SSD_XBC = SSD_INNER + 2 * SSD_GROUPS * SSD_STATE
SSD_CHUNK = 64

N_BRANCH = 3
IN_WIDTHS = (LRU_WIDTH, LRU_WIDTH, GLA_DK, GLA_DK, GLA_DV, GLA_DV, 2 * GLA_RANK,
             SSD_INNER, SSD_XBC, 2 * SSD_HEADS, N_BRANCH * D_MODEL)
IN_TOTAL = sum(IN_WIDTHS)

kernel_name = 'hybrid_lru_gla_ssd_prefix_dit'


def _split_cols(u):
    parts = []
    start = 0
    for w in IN_WIDTHS:
        parts.append(u[..., start:start + w])
        start += w
    return parts


def _rmsnorm(x, g):
    xf = x.astype(jnp.float32)
    y = xf * lax.rsqrt(jnp.mean(xf * xf, axis=-1, keepdims=True) + EPS)
    return (y * g.astype(jnp.float32)).astype(x.dtype)


def _to_col_major(h, rows):
    b, length, dm = h.shape
    return h.reshape(b, rows, GRID_W, dm).transpose(0, 2, 1, 3).reshape(b, length, dm)


def _from_col_major(h, rows):
    b, length, dm = h.shape
    return h.reshape(b, GRID_W, rows, dm).transpose(0, 2, 1, 3).reshape(b, length, dm)


def _dwconv(u, w, b, line_len):
    bn, length, ch = u.shape
    ul = u.reshape(bn, length // line_len, line_len, ch)
    left = (CONV_W - 1) // 2
    up = jnp.pad(ul, ((0, 0), (0, 0), (left, CONV_W - 1 - left), (0, 0)))
    out = b + w[0] * up[:, :, 0:line_len]
    for k in range(1, CONV_W):
        out = out + w[k] * up[:, :, k:k + line_len]
    return out.reshape(bn, length, ch)


def _flip(ts):
    return tuple(jnp.flip(t, axis=1) for t in ts)


def _bidir(step, ctx_f, lat_f, ctx_b, lat_b, s0, need_ctx):
    yc_f, sc_f = step(*ctx_f, s0)
    yl_f, _ = step(*lat_f, sc_f)
    yc_b, sc_b = step(*_flip(ctx_b), s0)
    yl_b, _ = step(*_flip(lat_b), sc_b)
    y_lat = yl_f + jnp.flip(yl_b, axis=1)
    y_ctx = yc_f + jnp.flip(yc_b, axis=1) if need_ctx else None
    return y_ctx, y_lat


def _to_chunks(t, chunk):
    b, length = t.shape[:2]
    return jnp.moveaxis(t.reshape((b, length // chunk, chunk) + t.shape[2:]), 1, 0)


def _from_chunks(t):
    n, b, chunk = t.shape[:3]
    return jnp.moveaxis(t, 0, 1).reshape((b, n * chunk) + t.shape[3:])


def _lru_gates(xa, wr, br, wi, bi, lam):
    bn, length, width = xa.shape
    xb = xa.reshape(bn, length, LRU_BLOCKS, LRU_BW)
    r = jax.nn.sigmoid(jnp.einsum('blnk,nkj->blnj', xb, wr).reshape(bn, length, width) + br)
    i = jax.nn.sigmoid(jnp.einsum('blnk,nkj->blnj', xb, wi).reshape(bn, length, width) + bi)
    log_a = (-LRU_C * jax.nn.softplus(-lam) * r).astype(jnp.float32)
    a = jnp.exp(log_a)
    b = jnp.sqrt(-jnp.expm1(2.0 * log_a)) * (i * xa).astype(jnp.float32)
    return a, b


def _lru_scan(a, b, h0):
    def combine(lhs, rhs):
        return lhs[0] * rhs[0], rhs[0] * lhs[1] + rhs[1]
    a_cum, h = lax.associative_scan(combine, (a, b), axis=1)
    h = h + a_cum * h0[:, None]
    return h, h[:, -1]


def _gla_chunked(q, k, v, logg, s0):
    mask = jnp.tril(jnp.ones((GLA_CHUNK, GLA_CHUNK), dtype=bool))

    def body(state, xs):
        qc, kc, vc, gc = xs
        bc = jnp.cumsum(gc, axis=1)
        btot = bc[:, -1]
        qe = qc * jnp.exp(bc)
        ke = kc * jnp.exp(-bc)
        att = jnp.where(mask, jnp.einsum('bthk,bshk->bhts', qe, ke), 0.0)
        o = jnp.einsum('bhts,bshv->bthv', att, vc) + jnp.einsum('bthk,bhkv->bthv', qe, state)
        kd = kc * jnp.exp(btot[:, None] - bc)
        state = state * jnp.exp(btot)[..., None] + jnp.einsum('bshk,bshv->bhkv', kd, vc)
        return state, o

    xs = tuple(_to_chunks(t, GLA_CHUNK) for t in (q, k, v, logg))
    state, o = lax.scan(body, s0, xs)
    return _from_chunks(o), state


def _gla_inputs(s, p):
    bn, length = s[2].shape[:2]
    q = (s[2] * GLA_DKH ** -0.5).reshape(bn, length, GLA_HEADS, GLA_DKH)
    k = s[3].reshape(bn, length, GLA_HEADS, GLA_DKH)
    v = s[4].reshape(bn, length, GLA_HEADS, GLA_DVH)
    low = s[6].reshape(bn, length, 2, GLA_RANK)
    dirs = []
    for d in range(2):
        z = jnp.einsum('blr,rk->blk', low[:, :, d], p['gla_alpha_up'][d]) + p['gla_alpha_b'][d]
        logg = jax.nn.log_sigmoid(z.astype(jnp.float32)) / GLA_TAU
        dirs.append((q, k, v, logg.reshape(bn, length, GLA_HEADS, GLA_DKH)))
    return dirs[0], dirs[1]


def _ssd_chunked(xdt, adt, bm, cm, s0):
    idx = jnp.arange(SSD_CHUNK)
    mask = (idx[:, None] >= idx[None, :])[None, :, :, None, None]

    def body(state, xs):
        xc, ac, bc, cc = xs
        cum = jnp.cumsum(ac, axis=1)
        seg = cum[:, :, None] - cum[:, None, :]
        lmat = jnp.exp(jnp.where(mask, seg, -jnp.inf))
        cb = jnp.einsum('btgn,bsgn->btsg', cc, bc)
        y = jnp.einsum('btsgh,bsghp->btghp', cb[..., None] * lmat, xc)
        y = y + jnp.einsum('btgn,bghnp->btghp', cc, state) * jnp.exp(cum)[..., None]
        dec = jnp.exp(cum[:, -1:] - cum)
        state = state * jnp.exp(cum[:, -1])[..., None, None] + jnp.einsum('bsgn,bsghp->bghnp', bc, xc * dec[..., None])
        return state, y

    xs = tuple(_to_chunks(t, SSD_CHUNK) for t in (xdt, adt, bm, cm))
    state, y = lax.scan(body, s0, xs)
    return _from_chunks(y), state


def _ssd_inputs(s, line_len, p):
    bn, length = s[8].shape[:2]
    xbc = jax.nn.silu(_dwconv(s[8], p['conv_c_w'], p['conv_c_b'], line_len))
    gn = SSD_GROUPS * SSD_STATE
    xs = xbc[..., :SSD_INNER].reshape(bn, length, SSD_GROUPS, SSD_HPG, SSD_HEADDIM)
    bm = xbc[..., SSD_INNER:SSD_INNER + gn].reshape(bn, length, SSD_GROUPS, SSD_STATE)
    cm = xbc[..., SSD_INNER + gn:].reshape(bn, length, SSD_GROUPS, SSD_STATE)
    dt_raw = s[9].reshape(bn, length, 2, SSD_HEADS).astype(jnp.float32)
    dirs = []
    for d in range(2):
        dt = jax.nn.softplus(dt_raw[:, :, d] + p['ssd_dt_bias'][d]).reshape(bn, length, SSD_GROUPS, SSD_HPG)
        a = -jnp.exp(p['ssd_a_log'][d].astype(jnp.float32)).reshape(SSD_GROUPS, SSD_HPG)
        dirs.append((xs * dt[..., None], dt * a, bm, cm))
    return xs, dirs[0], dirs[1]


def _finish(s, ya, yb, yc, xs, p):
    bn, length = s[1].shape[:2]
    pa = (ya * jax.nn.silu(s[1])) @ p['w_pa']
    ob = _rmsnorm(yb, p['gla_norm_g']).reshape(bn, length, GLA_DV) * jax.nn.silu(s[5])
    pb = ob @ p['w_pb']
    yc = (yc + p['ssd_d'].reshape(SSD_GROUPS, SSD_HPG, 1) * xs).reshape(bn, length, SSD_INNER)
    gsz = SSD_INNER // SSD_GROUPS
    oc = _rmsnorm((yc * jax.nn.silu(s[7])).reshape(bn, length, SSD_GROUPS, gsz),
                  p['ssd_norm_g'].reshape(SSD_GROUPS, gsz))
    pc = oc.reshape(bn, length, SSD_INNER) @ p['w_pc']
    g = jax.nn.sigmoid(s[10]).reshape(bn, length, N_BRANCH, D_MODEL)
    merged = g[:, :, 0] * pa + g[:, :, 1] * pb + g[:, :, 2] * pc
    return merged @ p['w_out']


def _mixer(h_ctx, h_lat, line_len, need_ctx, p):
    f32 = jnp.float32
    s_c = _split_cols(h_ctx @ p['w_in'])
    s_l = _split_cols(h_lat @ p['w_in'])
    bn = h_lat.shape[0]
    lc = h_ctx.shape[1]

    def lru_in(s, line):
        xa = _dwconv(s[0], p['conv_a_w'], p['conv_a_b'], line)
        return [_lru_gates(xa, p['lru_wr'][d], p['lru_br'][d], p['lru_wi'][d], p['lru_bi'][d], p['lru_lam'][d])
                for d in range(2)]
    a_c = lru_in(s_c, lc)
    a_l = lru_in(s_l, line_len)
    ya_c, ya_l = _bidir(_lru_scan, a_c[0], a_l[0], a_c[1], a_l[1],
                        jnp.zeros((bn, LRU_WIDTH), f32), need_ctx)

    bf_c, bb_c = _gla_inputs(s_c, p)
    bf_l, bb_l = _gla_inputs(s_l, p)
    yb_c, yb_l = _bidir(_gla_chunked, bf_c, bf_l, bb_c, bb_l,
                        jnp.zeros((bn, GLA_HEADS, GLA_DKH, GLA_DVH), f32), need_ctx)

    xs_c, cf_c, cb_c = _ssd_inputs(s_c, lc, p)
    xs_l, cf_l, cb_l = _ssd_inputs(s_l, line_len, p)
    yc_c, yc_l = _bidir(_ssd_chunked, cf_c, cf_l, cb_c, cb_l,
                        jnp.zeros((bn, SSD_GROUPS, SSD_HPG, SSD_STATE, SSD_HEADDIM), f32), need_ctx)

    out_lat = _finish(s_l, ya_l, yb_l, yc_l, xs_l, p)
    out_ctx = _finish(s_c, ya_c, yb_c, yc_c, xs_c, p) if need_ctx else None
    return out_ctx, out_lat


def setup_inputs(seed: int = 0) -> dict:
    key = jax.random.key(seed)
    ks = jax.random.split(key, 32)
    f32 = jnp.float32

    def nrm(k, shape, scale):
        return jax.random.normal(k, shape, f32) * scale

    L = DEPTH
    a0 = jax.random.uniform(ks[20], (L, 2, LRU_WIDTH), f32, 0.9, 0.999)
    p_a = a0 ** (1.0 / LRU_C)
    lru_lam = jnp.log(p_a) - jnp.log1p(-p_a)
    a_init = jax.random.uniform(ks[21], (L, 2, SSD_HEADS), f32, 1.0, 16.0)
    dt0 = jnp.exp(jax.random.uniform(ks[22], (L, 2, SSD_HEADS), f32, math.log(1e-3), math.log(1e-1)))
    return {
        'x': nrm(ks[0], (BATCH, SEQ, D_MODEL), 1.0),
        'c': nrm(ks[1], (BATCH, D_MODEL), 1.0),
        'ctx': nrm(ks[2], (BATCH, CTX_LEN, D_MODEL), 1.0),
        'c_ctx': nrm(ks[3], (D_MODEL,), 1.0),
        'ada_w': nrm(ks[4], (L, D_MODEL, 3 * D_MODEL), 0.5 * D_MODEL ** -0.5),
        'ada_b': nrm(ks[5], (L, 3 * D_MODEL), 0.01),
        'pre_g': 1.0 + nrm(ks[6], (L, D_MODEL), 0.05),
        'post_g': 1.0 + nrm(ks[7], (L, D_MODEL), 0.05),
        'w_in': nrm(ks[8], (L, D_MODEL, IN_TOTAL), D_MODEL ** -0.5),
        'conv_a_w': nrm(ks[9], (L, CONV_W, LRU_WIDTH), CONV_W ** -0.5),
        'conv_a_b': nrm(ks[10], (L, LRU_WIDTH), 0.01),
        'lru_wr': nrm(ks[11], (L, 2, LRU_BLOCKS, LRU_BW, LRU_BW), LRU_BW ** -0.5),
        'lru_br': nrm(ks[12], (L, 2, LRU_WIDTH), 0.01),
        'lru_wi': nrm(ks[13], (L, 2, LRU_BLOCKS, LRU_BW, LRU_BW), LRU_BW ** -0.5),
        'lru_bi': nrm(ks[14], (L, 2, LRU_WIDTH), 0.01),
        'lru_lam': lru_lam,
        'gla_alpha_up': nrm(ks[15], (L, 2, GLA_RANK, GLA_DK), GLA_RANK ** -0.5),
        'gla_alpha_b': nrm(ks[16], (L, 2, GLA_DK), 0.1),
        'gla_norm_g': 1.0 + nrm(ks[17], (L, GLA_DVH), 0.05),
        'conv_c_w': nrm(ks[18], (L, CONV_W, SSD_XBC), CONV_W ** -0.5),
        'conv_c_b': nrm(ks[19], (L, SSD_XBC), 0.01),
        'ssd_a_log': jnp.log(a_init),
        'ssd_dt_bias': dt0 + jnp.log(-jnp.expm1(-dt0)),
        'ssd_d': 1.0 + nrm(ks[23], (L, SSD_HEADS), 0.05),
        'ssd_norm_g': 1.0 + nrm(ks[24], (L, SSD_INNER), 0.05),
        'w_pa': nrm(ks[25], (L, LRU_WIDTH, D_MODEL), LRU_WIDTH ** -0.5),
        'w_pb': nrm(ks[26], (L, GLA_DV, D_MODEL), GLA_DV ** -0.5),
        'w_pc': nrm(ks[27], (L, SSD_INNER, D_MODEL), SSD_INNER ** -0.5),
        'w_out': nrm(ks[28], (L, D_MODEL, D_MODEL), D_MODEL ** -0.5),
    }


def reference(x, c, ctx, c_ctx, ada_w, ada_b, pre_g, post_g, w_in, conv_a_w, conv_a_b,
              lru_wr, lru_br, lru_wi, lru_bi, lru_lam, gla_alpha_up, gla_alpha_b, gla_norm_g,
              conv_c_w, conv_c_b, ssd_a_log, ssd_dt_bias, ssd_d, ssd_norm_g,
              w_pa, w_pb, w_pc, w_out):
    rows = x.shape[1] // GRID_W
    x_lat, x_ctx = x, ctx
    for l in range(DEPTH):
        p = {
            'w_in': w_in[l], 'conv_a_w': conv_a_w[l], 'conv_a_b': conv_a_b[l],
            'lru_wr': lru_wr[l], 'lru_br': lru_br[l], 'lru_wi': lru_wi[l], 'lru_bi': lru_bi[l],
            'lru_lam': lru_lam[l], 'gla_alpha_up': gla_alpha_up[l], 'gla_alpha_b': gla_alpha_b[l],
            'gla_norm_g': gla_norm_g[l], 'conv_c_w': conv_c_w[l], 'conv_c_b': conv_c_b[l],
            'ssd_a_log': ssd_a_log[l], 'ssd_dt_bias': ssd_dt_bias[l], 'ssd_d': ssd_d[l],
            'ssd_norm_g': ssd_norm_g[l], 'w_pa': w_pa[l], 'w_pb': w_pb[l], 'w_pc': w_pc[l],
            'w_out': w_out[l],
        }
        col_major = (l % 2 == 1)
        need_ctx = l < DEPTH - 1
        line_len = rows if col_major else GRID_W

        shift, scale, gate = jnp.split(jax.nn.silu(c) @ ada_w[l] + ada_b[l], 3, axis=-1)
        shift_c, scale_c, gate_c = jnp.split(jax.nn.silu(c_ctx) @ ada_w[l] + ada_b[l], 3, axis=-1)

        h_lat = _rmsnorm(x_lat, pre_g[l]) * (1.0 + scale[:, None]) + shift[:, None]
        h_ctx = _rmsnorm(x_ctx, pre_g[l]) * (1.0 + scale_c) + shift_c
        if col_major:
            h_lat = _to_col_major(h_lat, rows)

        o_ctx, o_lat = _mixer(h_ctx, h_lat, line_len, need_ctx, p)

        if col_major:
            o_lat = _from_col_major(o_lat, rows)
        x_lat = x_lat + gate[:, None] * _rmsnorm(o_lat, post_g[l])
        if need_ctx:
            x_ctx = x_ctx + gate_c * _rmsnorm(o_ctx, post_g[l])
    return x_lat
```

```cpp
#include <hip/hip_runtime.h>
#include <hip/hip_cooperative_groups.h>
#include <cstdio>
namespace cg = cooperative_groups;

typedef unsigned short bf16_t;
typedef short bf16x8 __attribute__((ext_vector_type(8)));
typedef float f32x4 __attribute__((ext_vector_type(4)));
typedef unsigned u32x4 __attribute__((ext_vector_type(4)));

#define DM 1024
#define TPB 2304
#define NU 13440
#define NIN 13408
#define SMEM_BYTES 73728
#define EPSV 1e-6f
#define NPH_PER_GROUP 33

#define U_LRUX 0
#define U_LRUG 1024
#define U_Q 2048
#define U_K 2560
#define U_V 3072
#define U_GG 4096
#define U_LOW 5120
#define U_Z 5152
#define U_XBC 7200
#define U_DT 10272
#define U_MG 10336
#define NY 8192

struct Params {
  const float *x, *c, *ctx, *c_ctx, *ada_w, *ada_b, *pre_g, *post_g, *w_in, *conv_a_w, *conv_a_b,
      *lru_wr, *lru_br, *lru_wi, *lru_bi, *lru_lam, *gla_up, *gla_b, *gla_norm_g, *conv_c_w, *conv_c_b,
      *ssd_a_log, *ssd_dt_bias, *ssd_d, *ssd_norm_g, *w_pa, *w_pb, *w_pc, *w_out;
  float* out;
  bf16_t *winT, *wpaT, *wpbT, *wpcT, *woutT, *wrT, *wiT;
  float *mod, *xctx, *obuf, *sspart;
  bf16_t *h, *u, *y, *acat, *acum, *xc;
  float *lruE, *lruH, *cumdt;
  char *gpre, *spre;
  unsigned* bar;
  int NB, ngroups;
};

typedef const Params __attribute__((address_space(4))) * CP;
__device__ __forceinline__ int tid_opaque() {
  int t = threadIdx.x;
  asm volatile("" : "+v"(t));
  return t;
}
typedef __bf16 bf16x2_t __attribute__((ext_vector_type(2)));
typedef float f32x2_t __attribute__((ext_vector_type(2)));
__device__ __forceinline__ unsigned pack2(float a, float b) {
  f32x2_t v = {a, b};
  bf16x2_t r = __builtin_convertvector(v, bf16x2_t);
  return __builtin_bit_cast(unsigned, r);
}
__device__ __forceinline__ bf16_t f2bf(float f) { return (bf16_t)(pack2(f, f) & 0xffffu); }
__device__ __forceinline__ float bf2f(bf16_t h) { return __uint_as_float(((unsigned)h) << 16); }
__device__ __forceinline__ float lo2f(unsigned w) { return __uint_as_float(w << 16); }
__device__ __forceinline__ float hi2f(unsigned w) { return __uint_as_float(w & 0xffff0000u); }
__device__ __forceinline__ float sigm(float x) { return __builtin_amdgcn_rcpf(1.f + __expf(-x)); }
__device__ __forceinline__ float silu(float x) { return x * __builtin_amdgcn_rcpf(1.f + __expf(-x)); }
__device__ __forceinline__ float softplus(float x) { return fmaxf(x, 0.f) + __logf(1.f + __expf(-fabsf(x))); }
__device__ __forceinline__ f32x4 mfma16(bf16x8 a, bf16x8 b, f32x4 c) { return __builtin_amdgcn_mfma_f32_16x16x32_bf16(a, b, c, 0, 0, 0); }
__device__ __forceinline__ int spos(int l, int t) { return (l & 1) ? ((t & 63) * 32 + (t >> 6)) : t; }

__device__ __forceinline__ void gemm_tile(const bf16_t* __restrict__ A, int lda, const bf16_t* __restrict__ Bt, int ldb, int K,
                                          int m0, int n0, f32x4 (&acc)[4][4], bf16_t* smem) {
  const int tid = tid_opaque(), lane = tid & 63, w = tid >> 6, wr = w >> 1, wc = w & 1, r = lane & 15, q = lane >> 4;
  char* sm = (char*)smem;
  const int srow = w * 8 + (lane >> 3);
  const int scol = ((lane & 7) ^ (((w & 1) << 2) + (lane >> 4))) * 8;
  const bf16_t* gA = A + (size_t)(m0 + srow) * lda + scol;
  const bf16_t* gB = Bt + (size_t)(n0 + srow) * ldb + scol;
  const int fsw = (r >> 1) & 7;
  const int nt = K >> 6;
#define GT_STAGE(buf, kt)                                                                                              \
  do {                                                                                                                 \
    _Pragma("unroll") for (int i = 0; i < 4; ++i) {                                                                    \
      __builtin_amdgcn_global_load_lds((const unsigned*)(gA + (size_t)(32 * i) * lda + (kt) * 64),                     \
                                       (unsigned*)(sm + (buf) * 32768 + i * 4096 + w * 1024), 16, 0, 0);               \
      __builtin_amdgcn_global_load_lds((const unsigned*)(gB + (size_t)(32 * i) * ldb + (kt) * 64),                     \
                                       (unsigned*)(sm + (buf) * 32768 + 16384 + i * 4096 + w * 1024), 16, 0, 0);       \
    }                                                                                                                  \
  } while (0)
  GT_STAGE(0, 0);
  asm volatile("s_waitcnt vmcnt(0)" ::: "memory");
  __syncthreads();
  for (int t = 0; t < nt; ++t) {
    const int cur = t & 1;
    if (t + 1 < nt) GT_STAGE(cur ^ 1, t + 1);
    const char* sA = sm + cur * 32768;
    const char* sB = sA + 16384;
#pragma unroll
    for (int ks = 0; ks < 2; ++ks) {
      bf16x8 af[4], bfr[4];
      const int co = ((ks * 4 + q) ^ fsw) * 16;
#pragma unroll
      for (int i = 0; i < 4; ++i) af[i] = *(const bf16x8*)(sA + (wr * 64 + i * 16 + r) * 128 + co);
#pragma unroll
      for (int j = 0; j < 4; ++j) bfr[j] = *(const bf16x8*)(sB + (wc * 64 + j * 16 + r) * 128 + co);
      __builtin_amdgcn_s_setprio(1);
#pragma unroll
      for (int i = 0; i < 4; ++i)
#pragma unroll
        for (int j = 0; j < 4; ++j) acc[i][j] = mfma16(bfr[j], af[i], acc[i][j]);
      __builtin_amdgcn_s_setprio(0);
    }
    asm volatile("s_waitcnt vmcnt(0)" ::: "memory");
    __syncthreads();
  }
#undef GT_STAGE
}

__device__ __forceinline__ void zero_acc(f32x4 (&acc)[4][4]) {
#pragma unroll
  for (int i = 0; i < 4; ++i)
#pragma unroll
    for (int j = 0; j < 4; ++j) acc[i][j] = (f32x4){0.f, 0.f, 0.f, 0.f};
}

template <int DB>
__device__ __forceinline__ void gemm_tile144(const bf16_t* __restrict__ A, int lda, const bf16_t* __restrict__ Bt, int ldb, int K,
                                             int m0, int n0, f32x4 (&acc)[9][2], bf16_t* smem) {
  const int tid = tid_opaque(), lane = tid & 63, w = tid >> 6, r = lane & 15, q = lane >> 4;
  char* sm = (char*)smem;
  const int srow = w * 8 + (lane >> 3);
  const int scol = ((lane & 7) ^ (((w & 1) << 2) + (lane >> 4))) * 8;
  const bf16_t* gA = A + (size_t)(m0 + srow) * lda + scol;
  const bf16_t* gB = Bt + (size_t)(n0 + srow) * ldb + scol;
  const int fsw = (r >> 1) & 7;
  const int nt = K >> 6;
#define GT_STAGE(buf, kt)                                                                                              \
  do {                                                                                                                 \
    _Pragma("unroll") for (int i = 0; i < 5; ++i) {                                                                    \
      if (i < 4 || w < 2)                                                                                              \
        __builtin_amdgcn_global_load_lds((const unsigned*)(gA + (size_t)(32 * i) * lda + (kt) * 64),                   \
                                         (unsigned*)(sm + (buf) * 34816 + i * 4096 + w * 1024), 16, 0, 0);             \
    }                                                                                                                  \
    _Pragma("unroll") for (int i = 0; i < 4; ++i) {                                                                    \
      __builtin_amdgcn_global_load_lds((const unsigned*)(gB + (size_t)(32 * i) * ldb + (kt) * 64),                     \
                                       (unsigned*)(sm + (buf) * 34816 + 18432 + i * 4096 + w * 1024), 16, 0, 0);       \
    }                                                                                                                  \
  } while (0)
  GT_STAGE(0, 0);
  asm volatile("s_waitcnt vmcnt(0)" ::: "memory");
  __syncthreads();
  for (int t = 0; t < nt; ++t) {
    const int cur = t & 1;
    if (t + 1 < nt) GT_STAGE(cur ^ 1, t + 1);
    const char* sA = sm + cur * 34816;
    const char* sB = sA + 18432;
    if (DB) {
      bf16x8 af[2][9], bfr[2][2];
#pragma unroll
      for (int ks = 0; ks < 2; ++ks) {
        const int co = ((ks * 4 + q) ^ fsw) * 16;
#pragma unroll
        for (int j = 0; j < 2; ++j) bfr[ks][j] = *(const bf16x8*)(sB + (w * 32 + j * 16 + r) * 128 + co);
#pragma unroll
        for (int i = 0; i < 9; ++i) af[ks][i] = *(const bf16x8*)(sA + (i * 16 + r) * 128 + co);
      }
      __builtin_amdgcn_s_setprio(1);
#pragma unroll
      for (int ks = 0; ks < 2; ++ks)
#pragma unroll
        for (int i = 0; i < 9; ++i)
#pragma unroll
          for (int j = 0; j < 2; ++j) acc[i][j] = mfma16(bfr[ks][j], af[ks][i], acc[i][j]);
      __builtin_amdgcn_s_setprio(0);
    } else {
#pragma unroll
      for (int ks = 0; ks < 2; ++ks) {
        const int co = ((ks * 4 + q) ^ fsw) * 16;
        bf16x8 af[9], bfr[2];
#pragma unroll
        for (int j = 0; j < 2; ++j) bfr[j] = *(const bf16x8*)(sB + (w * 32 + j * 16 + r) * 128 + co);
#pragma unroll
        for (int i = 0; i < 9; ++i) af[i] = *(const bf16x8*)(sA + (i * 16 + r) * 128 + co);
        __builtin_amdgcn_s_setprio(1);
#pragma unroll
        for (int i = 0; i < 9; ++i)
#pragma unroll
          for (int j = 0; j < 2; ++j) acc[i][j] = mfma16(bfr[j], af[i], acc[i][j]);
        __builtin_amdgcn_s_setprio(0);
      }
    }
    asm volatile("s_waitcnt vmcnt(0)" ::: "memory");
    __syncthreads();
  }
#undef GT_STAGE
}

__device__ void transpose_tile(const float* __restrict__ src, int ldsrc, int nvalid, bf16_t* __restrict__ dst, int lddst,
                               int k0, int n0, float* tile) {
  const int tid = tid_opaque(), c = tid & 63, r4 = tid >> 6;
  __syncthreads();
  {
    const int n = n0 + c;
    const int nc = (n < nvalid) ? n : (nvalid - 1);
    float v[16];
#pragma unroll
    for (int i = 0; i < 16; ++i) v[i] = src[(size_t)(k0 + i * 4 + r4) * ldsrc + nc];
#pragma unroll
    for (int i = 0; i < 16; ++i) tile[(i * 4 + r4) * 65 + c] = (n < nvalid) ? v[i] : 0.f;
  }
  __syncthreads();
#pragma unroll
  for (int it = 0; it < 2; ++it) {
    const int n = (tid >> 3) + 32 * it, kc = (tid & 7) * 8;
    u32x4 o;
#pragma unroll
    for (int e = 0; e < 4; ++e) o[e] = pack2(tile[(kc + 2 * e) * 65 + n], tile[(kc + 2 * e + 1) * 65 + n]);
    *(u32x4*)(dst + (size_t)(n0 + n) * lddst + k0 + kc) = o;
  }
}

#define N_LAYER_TILES 4640
__device__ void convert_layer_item(CP p, int l, int it, float* smf) {
  if (it < 3360) {
    int kt = it / 210, nt = it % 210;
    transpose_tile(p->w_in + (size_t)l * 1024 * NIN, NIN, NIN, p->winT + (size_t)l * NU * 1024, 1024, kt * 64, nt * 64, smf);
    return;
  }
  it -= 3360;
  if (it < 768) {
    int which = it / 256, rem = it % 256, kt = rem / 16, nt = rem % 16;
    const float* src = (which == 0 ? p->w_pa : which == 1 ? p->w_pb : p->w_out) + (size_t)l * 1024 * 1024;
    bf16_t* dst = (which == 0 ? p->wpaT : which == 1 ? p->wpbT : p->woutT) + (size_t)l * 1024 * 1024;
    transpose_tile(src, 1024, 1024, dst, 1024, kt * 64, nt * 64, smf);
    return;
  }
  it -= 768;
  {
    int kt = it / 16, nt = it % 16;
    transpose_tile(p->w_pc + (size_t)l * 2048 * 1024, 1024, 1024, p->wpcT + (size_t)l * 1024 * 2048, 2048, kt * 64, nt * 64, smf);
  }
}

__device__ void phase_prologue(CP p, float* smf) {
  const int tid = tid_opaque();
  const int NMOD = 48, N_LRU = 64 * 4;
  const int total = NMOD + 2 * N_LRU + N_LAYER_TILES;
  for (int item = blockIdx.x; item < total; item += gridDim.x) {
    int it = item;
    if (it < NMOD) {
      const int l = it / 12, nch = it % 12;
      __syncthreads();
      for (int i = tid; i < 17 * 1024; i += 256) {
        int bb = i >> 10, k = i & 1023;
        float cv = (bb < 16) ? p->c[bb * 1024 + k] : p->c_ctx[k];
        smf[i] = silu(cv);
      }
      __syncthreads();
      const int n = nch * 256 + tid;
      float acc[17];
      const float bias = p->ada_b[l * 3072 + n];
#pragma unroll
      for (int bb = 0; bb < 17; ++bb) acc[bb] = bias;
      const float* wp = p->ada_w + (size_t)l * 1024 * 3072 + n;
#pragma unroll 4
      for (int k = 0; k < 1024; ++k) {
        float wv = wp[(size_t)k * 3072];
#pragma unroll
        for (int bb = 0; bb < 17; ++bb) acc[bb] += smf[bb * 1024 + k] * wv;
      }
#pragma unroll
      for (int bb = 0; bb < 17; ++bb) p->mod[((size_t)l * 17 + bb) * 3072 + n] = acc[bb];
      continue;
    }
    it -= NMOD;
    if (it < 2 * N_LRU) {
      int which = it / N_LRU, rem = it % N_LRU, m = rem / 4, kt = (rem % 4) / 2, nt = rem % 2;
      const float* src = (which == 0 ? p->lru_wr : p->lru_wi) + (size_t)m * 128 * 128;
      bf16_t* dst = (which == 0 ? p->wrT : p->wiT) + (size_t)m * 128 * 128;
      transpose_tile(src, 128, 128, dst, 128, kt * 64, nt * 64, smf);
      continue;
    }
    it -= 2 * N_LRU;
    convert_layer_item(p, 0, it, smf);
  }
}

__device__ void phase_p1(CP p, int g, int l) {
  const int tid = tid_opaque(), lane = tid & 63, w = tid >> 6;
  const int nrows = p->NB * TPB;
  for (int rr = blockIdx.x * 4 + w; rr < nrows; rr += gridDim.x * 4) {
    const int bl = rr / TPB, pp = rr % TPB, b = g * p->NB + bl;
    const float* xin;
    float* xres;
    int orow, hrow, bb;
    if (pp < 256) {
      if (l == 4) continue;
      size_t off = ((size_t)b * 256 + pp) * 1024;
      xin = (l == 0 ? p->ctx : p->xctx) + off;
      xres = p->xctx + off;
      orow = hrow = bl * TPB + pp;
      bb = 16;
    } else {
      int t = pp - 256;
      size_t off = ((size_t)b * 2048 + t) * 1024;
      xin = (l == 0 ? p->x : p->out) + off;
      xres = p->out + off;
      orow = bl * TPB + 256 + spos(l - 1, t);
      hrow = bl * TPB + 256 + spos(l, t);
      bb = b;
    }
    float4 v[4];
#pragma unroll
    for (int i = 0; i < 4; ++i) v[i] = *(const float4*)(xin + (i * 64 + lane) * 4);
    if (l > 0) {
      float ss = (lane < 32) ? p->sspart[(size_t)orow * 32 + lane] : 0.f;
#pragma unroll
      for (int o = 16; o >= 1; o >>= 1) ss += __shfl_xor(ss, o);
      ss = __shfl(ss, 0);
      const float rinv = rsqrtf(ss * (1.f / 1024.f) + EPSV);
      const float* gate = p->mod + ((size_t)(l - 1) * 17 + bb) * 3072 + 2048;
      const float* pg = p->post_g + (l - 1) * 1024;
      const float* orp = p->obuf + (size_t)orow * 1024;
#pragma unroll
      for (int i = 0; i < 4; ++i) {
        int col = (i * 64 + lane) * 4;
        float4 o4 = *(const float4*)(orp + col), g4 = *(const float4*)(gate + col), p4 = *(const float4*)(pg + col);
        v[i].x += g4.x * (o4.x * rinv * p4.x);
        v[i].y += g4.y * (o4.y * rinv * p4.y);
        v[i].z += g4.z * (o4.z * rinv * p4.z);
        v[i].w += g4.w * (o4.w * rinv * p4.w);
      }
    }
#pragma unroll
    for (int i = 0; i < 4; ++i) *(float4*)(xres + (i * 64 + lane) * 4) = v[i];
    if (l < 4) {
      float sq = 0.f;
#pragma unroll
      for (int i = 0; i < 4; ++i) sq += v[i].x * v[i].x + v[i].y * v[i].y + v[i].z * v[i].z + v[i].w * v[i].w;
#pragma unroll
      for (int o = 32; o >= 1; o >>= 1) sq += __shfl_xor(sq, o);
      const float rinv = rsqrtf(sq * (1.f / 1024.f) + EPSV);
      const float* md = p->mod + ((size_t)l * 17 + bb) * 3072;
      const float* pg = p->pre_g + l * 1024;
      bf16_t* hr = p->h + (size_t)hrow * 1024;
#pragma unroll
      for (int i = 0; i < 4; ++i) {
        int col = (i * 64 + lane) * 4;
        float4 sh = *(const float4*)(md + col), sc = *(const float4*)(md + 1024 + col), p4 = *(const float4*)(pg + col);
        float a0 = (v[i].x * rinv * p4.x) * (1.f + sc.x) + sh.x;
        float a1 = (v[i].y * rinv * p4.y) * (1.f + sc.y) + sh.y;
        float a2 = (v[i].z * rinv * p4.z) * (1.f + sc.z) + sh.z;
        float a3 = (v[i].w * rinv * p4.w) * (1.f + sc.w) + sh.w;
        uint2 o2;
        o2.x = pack2(a0, a1);
        o2.y = pack2(a2, a3);
        *(uint2*)(hr + col) = o2;
      }
    }
  }
}

__device__ __forceinline__ int gi_scan_tile(int i) {
  return (i < 8) ? i : (i < 24) ? 16 + (i - 8) : (i < 25) ? 40 : 56 + (i - 25);
}
__device__ __forceinline__ int gi_fin_tile(int i) {
  return (i < 8) ? 8 + i : (i < 16) ? 32 + (i - 8) : (i < 31) ? 41 + (i - 16) : 81 + (i - 31);
}
struct GiTile { int mt, nt; };
__device__ __forceinline__ GiTile gi_decode(int idx, int MT, bool last_layer) {
  GiTile t;
  if (!last_layer) { t.mt = idx % MT; t.nt = idx / MT; return t; }
  const int nscan = 50 * MT;
  if (idx < nscan) { t.mt = idx % MT; t.nt = gi_scan_tile(idx / MT); return t; }
  const int j = idx - nscan, MTL = MT - MT / 9;
  const int mi = j % MTL;
  t.mt = (mi / 16) * 18 + 2 + (mi % 16);
  t.nt = gi_fin_tile(j / MTL);
  return t;
}
__device__ void phase_gemm_in(CP p, int l, bf16_t* smem) {
  const int tid = tid_opaque(), lane = tid & 63, w = tid >> 6, wr = w >> 1, wc = w & 1, r = lane & 15, q = lane >> 4;
  const bool lastl = (l == 3);
  const int MT = p->NB * TPB / 128, NT = NU / 128, ntiles = lastl ? 50 * MT + 55 * (MT - MT / 9) : MT * NT;
  const bf16_t* A = p->h;
  const bf16_t* Bt = p->winT + (size_t)l * NU * 1024;
  char* sm = (char*)smem;
  const int srow = w * 8 + (lane >> 3);
  const int scol = ((lane & 7) ^ (((w & 1) << 2) + (lane >> 4))) * 8;
  const int fsw = (r >> 1) & 7;
  int tile = blockIdx.x;
  if (tile >= ntiles) return;
#define GI_STAGE(buf, gA, gB, kt)                                                                                      \
  do {                                                                                                                 \
    _Pragma("unroll") for (int i = 0; i < 4; ++i) {                                                                    \
      __builtin_amdgcn_global_load_lds((const unsigned*)((gA) + (size_t)(32 * i) * 1024 + (kt) * 64),                  \
                                       (unsigned*)(sm + (buf) * 32768 + i * 4096 + w * 1024), 16, 0, 0);               \
      __builtin_amdgcn_global_load_lds((const unsigned*)((gB) + (size_t)(32 * i) * 1024 + (kt) * 64),                  \
                                       (unsigned*)(sm + (buf) * 32768 + 16384 + i * 4096 + w * 1024), 16, 0, 0);       \
    }                                                                                                                  \
  } while (0)
#define GI_READ(A0, B0, A1, B1, buf)                                                                                   \
    do {                                                                                                               \
      const char* sA_ = sm + (buf) * 32768;                                                                            \
      const char* sB_ = sA_ + 16384;                                                                                   \
      const int c0_ = ((0 * 4 + q) ^ fsw) * 16, c1_ = ((1 * 4 + q) ^ fsw) * 16;                                        \
      _Pragma("unroll") for (int i = 0; i < 4; ++i) A0[i] = *(const bf16x8*)(sA_ + (wr * 64 + i * 16 + r) * 128 + c0_); \
      _Pragma("unroll") for (int j = 0; j < 4; ++j) B0[j] = *(const bf16x8*)(sB_ + (wc * 64 + j * 16 + r) * 128 + c0_); \
      _Pragma("unroll") for (int i = 0; i < 4; ++i) A1[i] = *(const bf16x8*)(sA_ + (wr * 64 + i * 16 + r) * 128 + c1_); \
      _Pragma("unroll") for (int j = 0; j < 4; ++j) B1[j] = *(const bf16x8*)(sB_ + (wc * 64 + j * 16 + r) * 128 + c1_); \
    } while (0)
#define GI_MMA(AF, BF)                                                                                                 \
    do {                                                                                                               \
      _Pragma("unroll") for (int i = 0; i < 4; ++i)                                                                    \
        _Pragma("unroll") for (int j = 0; j < 4; ++j) acc[i][j] = mfma16(BF[j], AF[i], acc[i][j]);                     \
    } while (0)
#define GI_RAWBAR() do { asm volatile("s_waitcnt lgkmcnt(0)" ::: "memory"); __builtin_amdgcn_s_barrier(); asm volatile("" ::: "memory"); } while (0)
  GiTile tc = gi_decode(tile, MT, lastl);
  const bf16_t* gA = A + (size_t)(tc.mt * 128 + srow) * 1024 + scol;
  const bf16_t* gB = Bt + (size_t)(tc.nt * 128 + srow) * 1024 + scol;
  GI_STAGE(0, gA, gB, 0);
  GI_STAGE(1, gA, gB, 1);
  while (tile < ntiles) {
    const int mt = tc.mt, nt = tc.nt;
    const int next = tile + gridDim.x;
    const bool nvalid = next < ntiles;
    const GiTile tn = gi_decode(nvalid ? next : tile, MT, lastl);
    const bf16_t* gAn = A + (size_t)(tn.mt * 128 + srow) * 1024 + scol;
    const bf16_t* gBn = Bt + (size_t)(tn.nt * 128 + srow) * 1024 + scol;
    f32x4 acc[4][4];
    zero_acc(acc);
    bf16x8 af0[4], bf0[4], af1a[4], bf1a[4], af1b[4], bf1b[4];
    for (int t2 = 0; t2 < 8; ++t2) {
      if (t2 == 0) asm volatile("s_waitcnt vmcnt(0)" ::: "memory");
      else asm volatile("s_waitcnt vmcnt(8)" ::: "memory");
      GI_RAWBAR();
      GI_READ(af0, bf0, af1a, bf1a, 0);
      __builtin_amdgcn_s_setprio(1);
      if (t2 > 0) GI_MMA(af1b, bf1b);
      __builtin_amdgcn_s_setprio(0);
      GI_RAWBAR();
      if (t2 < 7) GI_STAGE(0, gA, gB, 2 * t2 + 2); else GI_STAGE(0, gAn, gBn, 0);
      __builtin_amdgcn_s_setprio(1);
      GI_MMA(af0, bf0);
      __builtin_amdgcn_s_setprio(0);
      asm volatile("s_waitcnt vmcnt(8)" ::: "memory");
      GI_RAWBAR();
      GI_READ(af0, bf0, af1b, bf1b, 1);
      __builtin_amdgcn_s_setprio(1);
      GI_MMA(af1a, bf1a);
      __builtin_amdgcn_s_setprio(0);
      GI_RAWBAR();
      if (t2 < 7) GI_STAGE(1, gA, gB, 2 * t2 + 3); else GI_STAGE(1, gAn, gBn, 1);
      __builtin_amdgcn_s_setprio(1);
      GI_MMA(af0, bf0);
      __builtin_amdgcn_s_setprio(0);
    }
    GI_MMA(af1b, bf1b);
#pragma unroll
    for (int i = 0; i < 4; ++i) {
      bf16_t* rowp = p->u + (size_t)(mt * 128 + wr * 64 + i * 16 + r) * NU + nt * 128 + wc * 64 + q * 4;
#pragma unroll
      for (int j = 0; j < 4; ++j) {
        uint2 o2;
        o2.x = pack2(acc[i][j][0], acc[i][j][1]);
        o2.y = pack2(acc[i][j][2], acc[i][j][3]);
        *(uint2*)(rowp + j * 16) = o2;
      }
    }
    tile = next;
    tc = tn;
    gA = gAn;
    gB = gBn;
  }
  asm volatile("s_waitcnt vmcnt(0)" ::: "memory");
  __syncthreads();
#undef GI_STAGE
#undef GI_READ
#undef GI_MMA
#undef GI_RAWBAR
}

__device__ __forceinline__ float4 ld4bf(const bf16_t* p) {
  uint2 w = *(const uint2*)p;
  return make_float4(lo2f(w.x), hi2f(w.x), lo2f(w.y), hi2f(w.y));
}
#define XC_LD 4096
__device__ __forceinline__ void ld8bf(const bf16_t* p, float (&o)[8]) {
  u32x4 a = *(const u32x4*)p;
#pragma unroll
  for (int e = 0; e < 4; ++e) { o[2 * e] = lo2f(a[e]); o[2 * e + 1] = hi2f(a[e]); }
}
__device__ void conv_block(CP p, int l, int bidx, int L) {
  const int idx = bidx * 256 + tid_opaque();
  const int ch = idx & 511, row4 = (idx >> 9) * 4;
  const int bl = row4 / TPB, pp = row4 % TPB;
  int lo, hi;
  if (pp < 256) { lo = 0; hi = 256; } else { int j = pp - 256; lo = 256 + j - (j % L); hi = lo + L; }
  const int c8 = ch * 8;
  int col; const float* wp; const float* bp; int wld; bool act;
  if (c8 < 1024) { col = U_LRUX + c8; wp = p->conv_a_w + (size_t)l * 4 * 1024 + c8; bp = p->conv_a_b + l * 1024 + c8; wld = 1024; act = false; }
  else { int cc = c8 - 1024; col = U_XBC + cc; wp = p->conv_c_w + (size_t)l * 4 * 3072 + cc; bp = p->conv_c_b + l * 3072 + cc; wld = 3072; act = true; }
  const bf16_t* base = p->u + (size_t)(bl * TPB) * NU + col;
  u32x4 raw[7];
#pragma unroll
  for (int k = 0; k < 7; ++k) {
    int rk = pp + k - 1;
    rk = rk < lo ? lo : (rk >= hi ? hi - 1 : rk);
    raw[k] = *(const u32x4*)(base + (size_t)rk * NU);
  }
  float wv[4][8], bsv[8];
  {
    const float4 b0 = *(const float4*)bp, b1 = *(const float4*)(bp + 4);
    bsv[0] = b0.x; bsv[1] = b0.y; bsv[2] = b0.z; bsv[3] = b0.w; bsv[4] = b1.x; bsv[5] = b1.y; bsv[6] = b1.z; bsv[7] = b1.w;
#pragma unroll
    for (int k = 0; k < 4; ++k) {
      const float4 w0 = *(const float4*)(wp + k * wld), w1 = *(const float4*)(wp + k * wld + 4);
      wv[k][0] = w0.x; wv[k][1] = w0.y; wv[k][2] = w0.z; wv[k][3] = w0.w; wv[k][4] = w1.x; wv[k][5] = w1.y; wv[k][6] = w1.z; wv[k][7] = w1.w;
    }
  }
  float xv[7][8];
#pragma unroll
  for (int k = 0; k < 7; ++k) {
    const int rk = pp + k - 1;
    const bool ok = (rk >= lo) && (rk < hi);
#pragma unroll
    for (int e = 0; e < 4; ++e) { xv[k][2 * e] = ok ? lo2f(raw[k][e]) : 0.f; xv[k][2 * e + 1] = ok ? hi2f(raw[k][e]) : 0.f; }
  }
#pragma unroll
  for (int t = 0; t < 4; ++t) {
    float acc[8];
#pragma unroll
    for (int e = 0; e < 8; ++e) {
      float a = bsv[e];
#pragma unroll
      for (int k = 0; k < 4; ++k) a += wv[k][e] * xv[t + k][e];
      acc[e] = act ? silu(a) : a;
    }
    u32x4 o;
    o[0] = pack2(acc[0], acc[1]); o[1] = pack2(acc[2], acc[3]); o[2] = pack2(acc[4], acc[5]); o[3] = pack2(acc[6], acc[7]);
    *(u32x4*)(p->xc + (size_t)(row4 + t) * XC_LD + c8) = o;
  }
}

template <int CS>
__device__ __forceinline__ int chunk_row0(int cc, int d) {
  const int nctx = 256 / CS, nlat = 2048 / CS;
  if (cc < nctx) return (d ? nctx - 1 - cc : cc) * CS;
  const int c = cc - nctx;
  return 256 + (d ? nlat - 1 - c : c) * CS;
}

typedef short s16x4 __attribute__((ext_vector_type(4)));
__device__ __forceinline__ bf16x8 tr_frag(const bf16_t* X, int ld, int s0, int c0, int r) {
  const bf16_t* a = X + (s0 + (r >> 2)) * ld + c0 + 4 * (r & 3);
  s16x4 lo = __builtin_amdgcn_ds_read_tr16_b64_v4i16((s16x4 __attribute__((address_space(3)))*)a);
  s16x4 hi = __builtin_amdgcn_ds_read_tr16_b64_v4i16((s16x4 __attribute__((address_space(3)))*)(a + 4 * ld));
  bf16x8 o;
  o[0] = lo[0]; o[1] = lo[1]; o[2] = lo[2]; o[3] = lo[3]; o[4] = hi[0]; o[5] = hi[1]; o[6] = hi[2]; o[7] = hi[3];
  return o;
}
__device__ __forceinline__ int kperm_off(int ch, int h) {
  const int b = ch >> 2, c = ch & 3;
  return b * 32 + ((c < 2) ? (16 * c + 8 * h) : (16 * (c - 2) + 4 + 8 * h));
}
#define GPRE_BYTES 41472
#define SPRE_BYTES 40960

__device__ void gla_pre(CP p, int l, int bl, int d, int hd, int cc2, char* smem) {
  const int tid = tid_opaque(), lane = tid & 63, w = tid >> 6, r = lane & 15, q = lane >> 4;
  bf16_t* sQe = (bf16_t*)smem;
  bf16_t* sKe = sQe + 64 * 136;
  bf16_t* sKeT = sKe + 64 * 136;
  float* sLow = (float*)(sKeT + 128 * 72);
  float* sTot = sLow + 64 * 16;
  float* sEb = sTot + 256;
  const int kk = tid & 127, half = tid >> 7;
  float up[16];
#pragma unroll
  for (int rr = 0; rr < 16; ++rr) up[rr] = p->gla_up[((size_t)(l * 2 + d) * 16 + rr) * 512 + hd * 128 + kk];
  const float zb = p->gla_b[(l * 2 + d) * 512 + hd * 128 + kk];
  const float qscale = 0.08838834764831845f;
  const bf16_t* ub = p->u + (size_t)bl * TPB * NU;
  u32x4 pq[4], pk[4];
  uint2 plw;
  {
    const int r0c = chunk_row0<64>(cc2 * 2, d);
#pragma unroll
    for (int it = 0; it < 4; ++it) {
      int cid = tid + 256 * it, t = cid >> 4, ch = cid & 15;
      const bf16_t* rp = ub + (size_t)(r0c + (d ? 63 - t : t)) * NU + U_Q + hd * 128 + ch * 8;
      pq[it] = *(const u32x4*)rp;
      pk[it] = *(const u32x4*)(rp + 512);
    }
    int t = tid >> 2, r0 = (tid & 3) * 4;
    plw = *(const uint2*)(ub + (size_t)(r0c + (d ? 63 - t : t)) * NU + U_LOW + d * 16 + r0);
  }
  for (int ci = 0; ci < 2; ++ci) {
  const int cc = cc2 * 2 + ci;
  char* blk = p->gpre + (size_t)((((bl * 2 + d) * 4 + hd) * 36) + cc) * GPRE_BYTES;
  __syncthreads();
  {
#pragma unroll
    for (int it = 0; it < 4; ++it) {
      int cid = tid + 256 * it, t = cid >> 4, ch = cid & 15;
      *(u32x4*)(sQe + t * 136 + ch * 8) = pq[it];
      *(u32x4*)(sKe + t * 136 + ch * 8) = pk[it];
    }
    int t = tid >> 2, r0 = (tid & 3) * 4;
    *(float4*)(sLow + t * 16 + r0) = make_float4(lo2f(plw.x), hi2f(plw.x), lo2f(plw.y), hi2f(plw.y));
  }
  __syncthreads();
  {
    const int cn = (ci == 0) ? cc + 1 : cc;
    const int rn = chunk_row0<64>(cn, d);
#pragma unroll
    for (int it = 0; it < 4; ++it) {
      int cid = tid + 256 * it, t = cid >> 4, ch = cid & 15;
      const bf16_t* rp = ub + (size_t)(rn + (d ? 63 - t : t)) * NU + U_Q + hd * 128 + ch * 8;
      pq[it] = *(const u32x4*)rp;
      pk[it] = *(const u32x4*)(rp + 512);
    }
    int t = tid >> 2, r0 = (tid & 3) * 4;
    plw = *(const uint2*)(ub + (size_t)(rn + (d ? 63 - t : t)) * NU + U_LOW + d * 16 + r0);
  }
  float lgv[32];
  {
    float tot = 0.f;
#pragma unroll
    for (int tt = 0; tt < 32; ++tt) {
      const int t = half * 32 + tt;
      float z = zb;
#pragma unroll
      for (int rr = 0; rr < 16; ++rr) z += sLow[t * 16 + rr] * up[rr];
      lgv[tt] = (fminf(z, 0.f) - __logf(1.f + __expf(-fabsf(z)))) * 0.0625f;
      tot += lgv[tt];
    }
    sTot[half * 128 + kk] = tot;
  }
  __syncthreads();
  {
    const float t0 = sTot[kk], t1 = sTot[128 + kk];
    float bc = half ? t0 : 0.f;
    if (half == 0) sEb[kk] = __expf(t0 + t1);
#pragma unroll
    for (int tt = 0; tt < 32; ++tt) {
      const int t = half * 32 + tt;
      bc += lgv[tt];
      float qv = bf2f(sQe[t * 136 + kk]);
      float kv = bf2f(sKe[t * 136 + kk]);
      float e = __expf(bc);
      sQe[t * 136 + kk] = f2bf(qv * qscale * e);
      bf16_t keb = f2bf(kv * __builtin_amdgcn_rcpf(e));
      sKe[t * 136 + kk] = keb;
      sKeT[kk * 72 + t] = keb;
    }
  }
  __syncthreads();
  f32x4 att[4];
#pragma unroll
  for (int nt = 0; nt < 4; ++nt) att[nt] = (f32x4){0.f, 0.f, 0.f, 0.f};
#pragma unroll
  for (int ks = 0; ks < 4; ++ks) {
    bf16x8 af = *(const bf16x8*)(sQe + (w * 16 + r) * 136 + ks * 32 + q * 8);
#pragma unroll
    for (int nt = 0; nt < 4; ++nt) {
      if (nt <= w) {
        bf16x8 bfr = *(const bf16x8*)(sKe + (nt * 16 + r) * 136 + ks * 32 + q * 8);
        att[nt] = mfma16(bfr, af, att[nt]);
      }
    }
  }
  {
    bf16_t* attg = (bf16_t*)(blk + 16384);
    const int t = w * 16 + r;
#pragma unroll
    for (int nt = 0; nt < 4; ++nt) {
      const int s0 = nt * 16 + q * 4;
      float a0 = (s0 + 0 <= t) ? att[nt][0] : 0.f, a1 = (s0 + 1 <= t) ? att[nt][1] : 0.f;
      float a2 = (s0 + 2 <= t) ? att[nt][2] : 0.f, a3 = (s0 + 3 <= t) ? att[nt][3] : 0.f;
      uint2 o2;
      o2.x = pack2(a0, a1);
      o2.y = pack2(a2, a3);
      *(uint2*)(attg + t * 64 + s0) = o2;
    }
    bf16_t* qeg = (bf16_t*)blk;
    bf16_t* ketg = (bf16_t*)(blk + 24576);
#pragma unroll
    for (int it = 0; it < 4; ++it) {
      int cid = tid + 256 * it;
      int t2 = cid >> 4, ch = cid & 15;
      {
        const u32x4 qv4 = *(const u32x4*)(sQe + t2 * 136 + ch * 8);
        uint2 h0, h1; h0.x = qv4[0]; h0.y = qv4[1]; h1.x = qv4[2]; h1.y = qv4[3];
        *(uint2*)(qeg + t2 * 128 + kperm_off(ch, 0)) = h0;
        *(uint2*)(qeg + t2 * 128 + kperm_off(ch, 1)) = h1;
      }
      int k2 = cid >> 3, c2 = cid & 7;
      *(u32x4*)(ketg + k2 * 64 + c2 * 8) = *(const u32x4*)(sKeT + k2 * 72 + c2 * 8);
    }
    if (tid < 128) ((float*)(blk + 40960))[tid] = sEb[tid];
  }
  }
}

__device__ void gla_chain(CP p, int l, int bl, int hd, int d, int vs, char* smem) {
  const int tid = tid_opaque(), lane = tid & 63, w = tid >> 6, r = lane & 15, q = lane >> 4;
  bf16_t* sQe = (bf16_t*)smem;
  bf16_t* sAtt = sQe + 64 * 136;
  bf16_t* sKeT = sAtt + 64 * 72;
  bf16_t* sV = sKeT + 128 * 72;
  float* sEb = (float*)(sV + 64 * 72);
  f32x4 S[8];
#pragma unroll
  for (int kt = 0; kt < 8; ++kt) S[kt] = (f32x4){0.f, 0.f, 0.f, 0.f};
  const bf16_t* ub = p->u + (size_t)bl * TPB * NU;
  bf16_t* yb = p->y + (size_t)bl * TPB * NY + 2048 + d * 1024 + hd * 256 + vs * 64;
  const char* blk0 = p->gpre + (size_t)(((bl * 2 + d) * 4 + hd) * 36) * GPRE_BYTES;
  const int vt = tid >> 2, vc = (tid & 3) * 16;
  u32x4 pq[4], pk[4], pa[2], pv[2];
  float pe;
  {
    const char* blk = blk0;
#pragma unroll
    for (int it = 0; it < 4; ++it) {
      pq[it] = *(const u32x4*)(blk + (size_t)(tid + 256 * it) * 16);
      pk[it] = *(const u32x4*)(blk + 24576 + (size_t)(tid + 256 * it) * 16);
    }
#pragma unroll
    for (int it = 0; it < 2; ++it) pa[it] = *(const u32x4*)(blk + 16384 + (size_t)(tid + 256 * it) * 16);
    pe = ((const float*)(blk + 40960))[tid & 127];
    const int row0 = chunk_row0<64>(0, d);
    const bf16_t* vp = ub + (size_t)(row0 + (d ? 63 - vt : vt)) * NU + U_V + hd * 256 + vs * 64 + vc;
    pv[0] = *(const u32x4*)vp;
    pv[1] = *(const u32x4*)(vp + 8);
  }
  for (int cc = 0; cc < 36; ++cc) {
    const int row0 = chunk_row0<64>(cc, d);
    __syncthreads();
#pragma unroll
    for (int it = 0; it < 4; ++it) {
      int cid = tid + 256 * it;
      *(u32x4*)(sQe + (cid >> 4) * 136 + (cid & 15) * 8) = pq[it];
      *(u32x4*)(sKeT + (cid >> 3) * 72 + (cid & 7) * 8) = pk[it];
    }
#pragma unroll
    for (int it = 0; it < 2; ++it) {
      int cid = tid + 256 * it;
      *(u32x4*)(sAtt + (cid >> 3) * 72 + (cid & 7) * 8) = pa[it];
    }
    if (tid < 128) sEb[tid] = pe;
    *(u32x4*)(sV + vt * 72 + vc) = pv[0];
    *(u32x4*)(sV + vt * 72 + vc + 8) = pv[1];
    __syncthreads();
    {
      const int cn = (cc + 1 < 36) ? cc + 1 : cc;
      const char* blk = blk0 + (size_t)cn * GPRE_BYTES;
#pragma unroll
      for (int it = 0; it < 4; ++it) {
        pq[it] = *(const u32x4*)(blk + (size_t)(tid + 256 * it) * 16);
        pk[it] = *(const u32x4*)(blk + 24576 + (size_t)(tid + 256 * it) * 16);
      }
#pragma unroll
      for (int it = 0; it < 2; ++it) pa[it] = *(const u32x4*)(blk + 16384 + (size_t)(tid + 256 * it) * 16);
      pe = ((const float*)(blk + 40960))[tid & 127];
      const int rown = chunk_row0<64>(cn, d);
      const bf16_t* vp = ub + (size_t)(rown + (d ? 63 - vt : vt)) * NU + U_V + hd * 256 + vs * 64 + vc;
      pv[0] = *(const u32x4*)vp;
      pv[1] = *(const u32x4*)(vp + 8);
    }
    f32x4 oacc[4];
#pragma unroll
    for (int mt = 0; mt < 4; ++mt) oacc[mt] = (f32x4){0.f, 0.f, 0.f, 0.f};
    bf16x8 vfr[2];
#pragma unroll
    for (int ks = 0; ks < 2; ++ks) vfr[ks] = tr_frag(sV, 72, ks * 32 + q * 8, w * 16, r);
#pragma unroll
    for (int ks = 0; ks < 2; ++ks) {
#pragma unroll
      for (int mt = 0; mt < 4; ++mt) {
        bf16x8 af = *(const bf16x8*)(sAtt + (mt * 16 + r) * 72 + ks * 32 + q * 8);
        oacc[mt] = mfma16(vfr[ks], af, oacc[mt]);
      }
    }
#pragma unroll
    for (int ks = 0; ks < 4; ++ks) {
      union { bf16x8 v; unsigned u[4]; } bs;
      bs.u[0] = pack2(S[2 * ks][0], S[2 * ks][1]);
      bs.u[1] = pack2(S[2 * ks][2], S[2 * ks][3]);
      bs.u[2] = pack2(S[2 * ks + 1][0], S[2 * ks + 1][1]);
      bs.u[3] = pack2(S[2 * ks + 1][2], S[2 * ks + 1][3]);
#pragma unroll
      for (int mt = 0; mt < 4; ++mt) {
        bf16x8 af = *(const bf16x8*)(sQe + (mt * 16 + r) * 136 + ks * 32 + q * 8);
        oacc[mt] = mfma16(bs.v, af, oacc[mt]);
      }
    }
#pragma unroll
    for (int mt = 0; mt < 4; ++mt) {
      const int t = mt * 16 + r;
      const int orow = row0 + (d ? 63 - t : t);
      uint2 o2;
      o2.x = pack2(oacc[mt][0], oacc[mt][1]);
      o2.y = pack2(oacc[mt][2], oacc[mt][3]);
      *(uint2*)(yb + (size_t)orow * NY + w * 16 + q * 4) = o2;
    }
#pragma unroll
    for (int ks = 0; ks < 2; ++ks) {
#pragma unroll
      for (int kt = 0; kt < 8; ++kt) {
        bf16x8 af = *(const bf16x8*)(sKeT + (kt * 16 + r) * 72 + ks * 32 + q * 8);
        S[kt] = mfma16(af, vfr[ks], S[kt]);
      }
    }
#pragma unroll
    for (int kt = 0; kt < 8; ++kt) {
      float4 eb = *(const float4*)(sEb + kt * 16 + q * 4);
      S[kt][0] *= eb.x; S[kt][1] *= eb.y; S[kt][2] *= eb.z; S[kt][3] *= eb.w;
    }
  }
}

__device__ void ssd_pre(CP p, int l, int bl, int d, int g, int cc, char* smem) {
  const int tid = tid_opaque(), lane = tid & 63, w = tid >> 6, r = lane & 15, q = lane >> 4;
  bf16_t* sB = (bf16_t*)smem;
  bf16_t* sC = sB + 64 * 136;
  const bf16_t* ub = p->u + (size_t)bl * TPB * NU;
  const int row0 = chunk_row0<64>(cc, d);
  char* blk = p->spre + (size_t)((((bl * 2 + d) * 4 + g) * 36) + cc) * SPRE_BYTES;
  __syncthreads();
#pragma unroll
  for (int it = 0; it < 4; ++it) {
    int cid = tid + 256 * it, t = cid >> 4, ch = cid & 15;
    int orow = row0 + (d ? 63 - t : t);
    const bf16_t* rp = p->xc + (size_t)(bl * TPB + orow) * XC_LD + 1024 + 2048 + g * 128 + ch * 8;
    u32x4 bv = *(const u32x4*)rp;
    u32x4 cv = *(const u32x4*)(rp + 512);
    *(u32x4*)(sB + t * 136 + ch * 8) = bv;
    *(u32x4*)(sC + t * 136 + ch * 8) = cv;
    {
      uint2 h0, h1; h0.x = cv[0]; h0.y = cv[1]; h1.x = cv[2]; h1.y = cv[3];
      bf16_t* csg = (bf16_t*)blk + t * 128;
      *(uint2*)(csg + kperm_off(ch, 0)) = h0;
      *(uint2*)(csg + kperm_off(ch, 1)) = h1;
    }
  }
  {
    const int orow = row0 + (d ? 63 - lane : lane);
#pragma unroll
    for (int i = 0; i < 2; ++i) {
      const int hh = g * 8 + w * 2 + i;
      const float dtb = p->ssd_dt_bias[(l * 2 + d) * 32 + hh];
      const float aneg = -__expf(p->ssd_a_log[(l * 2 + d) * 32 + hh]);
      float raw = bf2f(ub[(size_t)orow * NU + U_DT + d * 32 + hh]);
      float dtv = softplus(raw + dtb);
      float cs = dtv * aneg;
#pragma unroll
      for (int o = 1; o < 64; o <<= 1) {
        float nb = __shfl_up(cs, o);
        if (lane >= o) cs += nb;
      }
      float* cd = p->cumdt + ((size_t)((bl * 2 + d) * 32 + hh) * 2) * TPB + cc * 64 + lane;
      cd[0] = cs * 1.4426950408889634f;
      cd[TPB] = dtv;
    }
  }
  __syncthreads();
  f32x4 cb[4];
#pragma unroll
  for (int nt = 0; nt < 4; ++nt) cb[nt] = (f32x4){0.f, 0.f, 0.f, 0.f};
#pragma unroll
  for (int ks = 0; ks < 4; ++ks) {
    bf16x8 af = *(const bf16x8*)(sC + (w * 16 + r) * 136 + ks * 32 + q * 8);
#pragma unroll
    for (int nt = 0; nt < 4; ++nt) {
      if (nt <= w) {
        bf16x8 bfr = *(const bf16x8*)(sB + (nt * 16 + r) * 136 + ks * 32 + q * 8);
        cb[nt] = mfma16(bfr, af, cb[nt]);
      }
    }
  }
  {
    bf16_t* cbg = (bf16_t*)(blk + 32768);
    const int t = w * 16 + r;
#pragma unroll
    for (int nt = 0; nt < 4; ++nt) {
      const int s0 = nt * 16 + q * 4;
      uint2 o2;
      o2.x = pack2((s0 + 0 <= t) ? cb[nt][0] : 0.f, (s0 + 1 <= t) ? cb[nt][1] : 0.f);
      o2.y = pack2((s0 + 2 <= t) ? cb[nt][2] : 0.f, (s0 + 3 <= t) ? cb[nt][3] : 0.f);
      *(uint2*)(cbg + t * 64 + s0) = o2;
    }
    bf16_t* btg = (bf16_t*)(blk + 16384);
    const int n = tid >> 1, hf = tid & 1;
#pragma unroll
    for (int c4 = 0; c4 < 4; ++c4) {
      u32x4 o;
#pragma unroll
      for (int e = 0; e < 4; ++e) {
        int s = hf * 32 + c4 * 8 + e * 2;
        o[e] = (unsigned)sB[s * 136 + n] | ((unsigned)sB[(s + 1) * 136 + n] << 16);
      }
      *(u32x4*)(btg + n * 64 + hf * 32 + c4 * 8) = o;
    }
  }
}

__device__ void ssd_chain(CP p, int l, int bl, int hh, int d, char* smem) {
  const int tid = tid_opaque(), lane = tid & 63, w = tid >> 6, r = lane & 15, q = lane >> 4;
  bf16_t* sC = (bf16_t*)smem;
  bf16_t* sBT = sC + 64 * 136;
  bf16_t* sM = sBT + 128 * 72;
  bf16_t* sXd = sM + 64 * 72;
  bf16_t* sXdd = sXd + 64 * 72;
  float* sCum = (float*)(sXdd + 64 * 72);
  const int g = hh >> 3;
  __builtin_amdgcn_s_setprio(3);
  f32x4 S[8];
#pragma unroll
  for (int nt = 0; nt < 8; ++nt) S[nt] = (f32x4){0.f, 0.f, 0.f, 0.f};
  const bf16_t* ub = p->u + (size_t)bl * TPB * NU;
  bf16_t* yb = p->y + (size_t)bl * TPB * NY + 4096 + d * 2048 + hh * 64;
  const char* blk0 = p->spre + (size_t)(((bl * 2 + d) * 4 + g) * 36) * SPRE_BYTES;
  const float* cd0 = p->cumdt + ((size_t)((bl * 2 + d) * 32 + hh) * 2) * TPB;
  const int xt = tid >> 2, xc = (tid & 3) * 16;
  const int mt0 = tid >> 3, ms0 = (tid & 7) * 8;
  u32x4 pc[4], pbt[4], pcb[2], px[2];
  const unsigned vo16 = (unsigned)tid * 16u;
  const unsigned voX = (unsigned)(((d ? 63 - xt : xt) * XC_LD + xc) * 2);
  const char* xbase = (const char*)(p->xc + (size_t)(bl * TPB) * XC_LD + 1024 + hh * 64);
  f32x4 pcs[2];
  float pct[2], pcx, pdx, pcl, pcw;
  {
    const char* blk = blk0;
    const float* cd = cd0;
#pragma unroll
    for (int it = 0; it < 4; ++it) {
      pc[it] = *(const u32x4*)(blk + (vo16 + 4096u * it));
      pbt[it] = *(const u32x4*)(blk + 16384 + (vo16 + 4096u * it));
    }
#pragma unroll
    for (int it = 0; it < 2; ++it) {
      pcb[it] = *(const u32x4*)(blk + 32768 + (vo16 + 4096u * it));
      pct[it] = cd[mt0 + 32 * it];
      pcs[it] = *(const f32x4*)(cd + ms0 + 4 * it);
    }
    pcx = cd[xt];
    pdx = cd[TPB + xt];
    pcl = cd[63];
    pcw = cd[tid & 63];
    const int row0 = chunk_row0<64>(0, d);
    const char* xp = xbase + (size_t)row0 * (XC_LD * 2);
    px[0] = *(const u32x4*)(xp + voX);
    px[1] = *(const u32x4*)(xp + (voX + 16u));
  }
  for (int cc = 0; cc < 36; ++cc) {
    const int row0 = chunk_row0<64>(cc, d);
    __syncthreads();
    const float cumlast = pcl;
#pragma unroll
    for (int it = 0; it < 4; ++it) {
      int cid = tid + 256 * it;
      *(u32x4*)(sC + (cid >> 4) * 136 + (cid & 15) * 8) = pc[it];
      *(u32x4*)(sBT + (cid >> 3) * 72 + (cid & 7) * 8) = pbt[it];
    }
#pragma unroll
    for (int it = 0; it < 2; ++it) {
      const int t = mt0 + 32 * it;
      u32x4 o;
#pragma unroll
      for (int e = 0; e < 4; ++e) {
        const float c0 = (e < 2) ? pcs[0][2 * e] : pcs[1][2 * e - 4];
        const float c1 = (e < 2) ? pcs[0][2 * e + 1] : pcs[1][2 * e - 3];
        float m0 = lo2f(pcb[it][e]) * __builtin_amdgcn_exp2f(fminf(pct[it] - c0, 0.f));
        float m1 = hi2f(pcb[it][e]) * __builtin_amdgcn_exp2f(fminf(pct[it] - c1, 0.f));
        o[e] = pack2(m0, m1);
      }
      *(u32x4*)(sM + t * 72 + ms0) = o;
    }
    {
      const float dec = __builtin_amdgcn_exp2f(cumlast - pcx) * pdx;
#pragma unroll
      for (int hv = 0; hv < 2; ++hv) {
        u32x4 o1, o2;
#pragma unroll
        for (int e = 0; e < 4; ++e) {
          const unsigned wv = px[hv][e];
          const float x0 = lo2f(wv), x1 = hi2f(wv);
          o1[e] = pack2(x0 * pdx, x1 * pdx);
          o2[e] = pack2(x0 * dec, x1 * dec);
        }
        *(u32x4*)(sXd + xt * 72 + xc + hv * 8) = o1;
        *(u32x4*)(sXdd + xt * 72 + xc + hv * 8) = o2;
      }
    }
    if (tid < 64) sCum[tid] = pcw;
    __syncthreads();
    {
      const int cn = (cc + 1 < 36) ? cc + 1 : cc;
      const char* blk = blk0 + (size_t)cn * SPRE_BYTES;
      const float* cd = cd0 + cn * 64;
#pragma unroll
      for (int it = 0; it < 4; ++it) {
        pc[it] = *(const u32x4*)(blk + (vo16 + 4096u * it));
        pbt[it] = *(const u32x4*)(blk + 16384 + (vo16 + 4096u * it));
      }
#pragma unroll
      for (int it = 0; it < 2; ++it) {
        pcb[it] = *(const u32x4*)(blk + 32768 + (vo16 + 4096u * it));
        pct[it] = cd[mt0 + 32 * it];
        pcs[it] = *(const f32x4*)(cd + ms0 + 4 * it);
      }
      pcx = cd[xt];
      pdx = cd[TPB + xt];
      pcl = cd[63];
      pcw = cd[tid & 63];
      const int rown = chunk_row0<64>(cn, d);
      const char* xp = xbase + (size_t)rown * (XC_LD * 2);
      px[0] = *(const u32x4*)(xp + voX);
      px[1] = *(const u32x4*)(xp + (voX + 16u));
    }
    f32x4 y1[4], y2[4];
#pragma unroll
    for (int mt = 0; mt < 4; ++mt) { y1[mt] = (f32x4){0.f, 0.f, 0.f, 0.f}; y2[mt] = (f32x4){0.f, 0.f, 0.f, 0.f}; }
#pragma unroll
    for (int ks = 0; ks < 2; ++ks) {
      bf16x8 bfr = tr_frag(sXd, 72, ks * 32 + q * 8, w * 16, r);
#pragma unroll
      for (int mt = 0; mt < 4; ++mt) {
        bf16x8 af = *(const bf16x8*)(sM + (mt * 16 + r) * 72 + ks * 32 + q * 8);
        y1[mt] = mfma16(bfr, af, y1[mt]);
      }
    }
#pragma unroll
    for (int ks = 0; ks < 4; ++ks) {
      union { bf16x8 v; unsigned u[4]; } bs;
      bs.u[0] = pack2(S[2 * ks][0], S[2 * ks][1]);
      bs.u[1] = pack2(S[2 * ks][2], S[2 * ks][3]);
      bs.u[2] = pack2(S[2 * ks + 1][0], S[2 * ks + 1][1]);
      bs.u[3] = pack2(S[2 * ks + 1][2], S[2 * ks + 1][3]);
#pragma unroll
      for (int mt = 0; mt < 4; ++mt) {
        bf16x8 af = *(const bf16x8*)(sC + (mt * 16 + r) * 136 + ks * 32 + q * 8);
        y2[mt] = mfma16(bs.v, af, y2[mt]);
      }
    }
#pragma unroll
    for (int mt = 0; mt < 4; ++mt) {
      const int t = mt * 16 + r;
      const int orow = row0 + (d ? 63 - t : t);
      const float ec = __builtin_amdgcn_exp2f(sCum[t]);
      uint2 o2;
      o2.x = pack2(y1[mt][0] + ec * y2[mt][0], y1[mt][1] + ec * y2[mt][1]);
      o2.y = pack2(y1[mt][2] + ec * y2[mt][2], y1[mt][3] + ec * y2[mt][3]);
      *(uint2*)(yb + (size_t)orow * NY + w * 16 + q * 4) = o2;
    }
    const float dl = __builtin_amdgcn_exp2f(cumlast);
#pragma unroll
    for (int nt = 0; nt < 8; ++nt) { S[nt][0] *= dl; S[nt][1] *= dl; S[nt][2] *= dl; S[nt][3] *= dl; }
#pragma unroll
    for (int ks = 0; ks < 2; ++ks) {
      bf16x8 bfr = tr_frag(sXdd, 72, ks * 32 + q * 8, w * 16, r);
#pragma unroll
      for (int nt = 0; nt < 8; ++nt) {
        bf16x8 af = *(const bf16x8*)(sBT + (nt * 16 + r) * 72 + ks * 32 + q * 8);
        S[nt] = mfma16(af, bfr, S[nt]);
      }
    }
  }
  __builtin_amdgcn_s_setprio(0);
}

__device__ void lru_pre(CP p, int l, int bl, int n, int d, int c4, char* smem) {
  const int tid = tid_opaque(), lane = tid & 63, w = tid >> 6, r = lane & 15, q = lane >> 4;
  bf16_t* sXa = (bf16_t*)smem;
  float* sA = (float*)(smem + 32 * 136 * 2);
  float* sB = sA + 32 * 128;
  float* sE = sB + 32 * 128;
  const int mi = ((l * 2 + d) * 8 + n);
  const bf16_t* wr = p->wrT + (size_t)mi * 128 * 128;
  const bf16_t* wi = p->wiT + (size_t)mi * 128 * 128;
  bf16x8 fr[2][4], fi[2][4];
#pragma unroll
  for (int ct = 0; ct < 2; ++ct)
#pragma unroll
    for (int ks = 0; ks < 4; ++ks) {
      fr[ct][ks] = *(const bf16x8*)(wr + (w * 32 + ct * 16 + r) * 128 + ks * 32 + q * 8);
      fi[ct][ks] = *(const bf16x8*)(wi + (w * 32 + ct * 16 + r) * 128 + ks * 32 + q * 8);
    }
  float br[2][4], bi[2][4], cl[2][4];
#pragma unroll
  for (int ct = 0; ct < 2; ++ct)
#pragma unroll
    for (int e = 0; e < 4; ++e) {
      int j = (l * 2 + d) * 1024 + n * 128 + w * 32 + ct * 16 + q * 4 + e;
      br[ct][e] = p->lru_br[j];
      bi[ct][e] = p->lru_bi[j];
      cl[ct][e] = -8.f * softplus(-p->lru_lam[j]);
    }
  const bf16_t* ub = p->xc + (size_t)bl * TPB * XC_LD + n * 128;
  bf16_t* yb = p->y + (size_t)bl * TPB * NY + d * 1024 + n * 128;
  bf16_t* ab = p->acum + (size_t)bl * TPB * 2048 + d * 1024 + n * 128;
  u32x4 pxa[2];
  {
    const int r0 = chunk_row0<32>(c4 * 4, d);
#pragma unroll
    for (int it = 0; it < 2; ++it) {
      int cid = tid + 256 * it, t = cid >> 4, ch = cid & 15;
      pxa[it] = *(const u32x4*)(ub + (size_t)(r0 + (d ? 31 - t : t)) * XC_LD + ch * 8);
    }
  }
  for (int ci = 0; ci < 4; ++ci) {
    const int cc = c4 * 4 + ci;
    const int row0 = chunk_row0<32>(cc, d);
    __syncthreads();
#pragma unroll
    for (int it = 0; it < 2; ++it) {
      int cid = tid + 256 * it, t = cid >> 4, ch = cid & 15;
      *(u32x4*)(sXa + t * 136 + ch * 8) = pxa[it];
    }
    __syncthreads();
    {
      const int cn = (ci + 1 < 4) ? cc + 1 : cc;
      const int rn = chunk_row0<32>(cn, d);
#pragma unroll
      for (int it = 0; it < 2; ++it) {
        int cid = tid + 256 * it, t = cid >> 4, ch = cid & 15;
        pxa[it] = *(const u32x4*)(ub + (size_t)(rn + (d ? 31 - t : t)) * XC_LD + ch * 8);
      }
    }
    f32x4 aR[2][2], aI[2][2];
#pragma unroll
    for (int mt = 0; mt < 2; ++mt)
#pragma unroll
      for (int ct = 0; ct < 2; ++ct) { aR[mt][ct] = (f32x4){0.f, 0.f, 0.f, 0.f}; aI[mt][ct] = (f32x4){0.f, 0.f, 0.f, 0.f}; }
#pragma unroll
    for (int ks = 0; ks < 4; ++ks) {
#pragma unroll
      for (int mt = 0; mt < 2; ++mt) {
        bf16x8 af = *(const bf16x8*)(sXa + (mt * 16 + r) * 136 + ks * 32 + q * 8);
#pragma unroll
        for (int ct = 0; ct < 2; ++ct) {
          aR[mt][ct] = mfma16(fr[ct][ks], af, aR[mt][ct]);
          aI[mt][ct] = mfma16(fi[ct][ks], af, aI[mt][ct]);
        }
      }
    }
#pragma unroll
    for (int mt = 0; mt < 2; ++mt)
#pragma unroll
      for (int ct = 0; ct < 2; ++ct) {
        const int t = mt * 16 + r, j0 = w * 32 + ct * 16 + q * 4;
        float av[4], bv[4];
#pragma unroll
        for (int e = 0; e < 4; ++e) {
          float xav = bf2f(sXa[t * 136 + j0 + e]);
          float rg = sigm(aR[mt][ct][e] + br[ct][e]);
          float ig = sigm(aI[mt][ct][e] + bi[ct][e]);
          float la = cl[ct][e] * rg;
          av[e] = __expf(la);
          bv[e] = __builtin_amdgcn_sqrtf(fmaxf(1.f - __expf(2.f * la), 0.f)) * (ig * xav);
        }
        *(float4*)(sA + t * 128 + j0) = make_float4(av[0], av[1], av[2], av[3]);
        *(float4*)(sB + t * 128 + j0) = make_float4(bv[0], bv[1], bv[2], bv[3]);
      }
    __syncthreads();
    {
      const int j = tid & 127, th = (tid >> 7) * 16;
      float hv[16], av[16];
      float hl = 0.f, ac = 1.f;
#pragma unroll
      for (int t = 0; t < 16; ++t) {
        const float a = sA[(th + t) * 128 + j];
        hl = a * hl + sB[(th + t) * 128 + j];
        ac *= a;
        hv[t] = hl; av[t] = ac;
      }
      if (tid < 128) *(float2*)(sE + 2 * j) = make_float2(ac, hl);
      __syncthreads();
      if (tid >= 128) {
        const float2 e1 = *(const float2*)(sE + 2 * j);
#pragma unroll
        for (int t = 0; t < 16; ++t) { hv[t] += av[t] * e1.y; av[t] *= e1.x; }
      }
#pragma unroll
      for (int t = 0; t < 16; ++t) {
        const int tt = th + t;
        const int orow = row0 + (d ? 31 - tt : tt);
        yb[(size_t)orow * NY + j] = f2bf(hv[t]);
        ab[(size_t)orow * 2048 + j] = f2bf(av[t]);
      }
      if (tid >= 128) {
        float2* ep = (float2*)p->lruE + ((size_t)((bl * 2 + d) * 72 + cc) * 1024 + n * 128 + j);
        *ep = make_float2(av[15], hv[15]);
      }
    }
  }
}

__device__ void lru_chain(CP p, int bl, int d, int qt) {
  const int tid = tid_opaque();
  const int ch = qt * 256 + tid;
  const float2* ep = (const float2*)p->lruE + (size_t)((bl * 2 + d) * 72) * 1024 + ch;
  float* hp = p->lruH + (size_t)((bl * 2 + d) * 72) * 1024 + ch;
  float h = 0.f;
#pragma unroll 8
  for (int c = 0; c < 72; ++c) {
    hp[(size_t)c * 1024] = h;
    float2 e = ep[(size_t)c * 1024];
    h = e.x * h + e.y;
  }
}

__device__ void phase_pre_a(CP p, int l, char* smem) {
  const int NB = p->NB;
  const int L = (l & 1) ? 32 : 64;
  const int n_gla = NB * 2 * 4 * 18, n_conv = NB * TPB / 2;
  for (int item = blockIdx.x; item < n_gla + n_conv; item += gridDim.x) {
    if (item < n_gla) {
      int cc2 = item % 18, rest = item / 18;
      int bl = rest >> 3, d = (rest >> 2) & 1, hd = rest & 3;
      if (NB == 4 && gridDim.x == 512) {
        const int x = item & 7, k = item >> 3, team = x * 4 + k / 18;
        cc2 = k % 18; bl = team >> 3; hd = (team >> 1) & 3; d = team & 1;
      }
      gla_pre(p, l, bl, d, hd, cc2, smem);
    } else {
      conv_block(p, l, item - n_gla, L);
    }
  }
}

__device__ void phase_pre_b(CP p, int l, char* smem) {
  const int NB = p->NB;
  const int n_lru = NB * 8 * 2 * 18, n_ssd = NB * 2 * 4 * 36;
  for (int item = blockIdx.x; item < n_lru + n_ssd; item += gridDim.x) {
    if (item < n_lru) {
      int c4 = item % 18, rest = item / 18;
      lru_pre(p, l, rest >> 4, (rest >> 1) & 7, rest & 1, c4, smem);
    } else {
      int it = item - n_lru;
      int cc = it % 36, rest = it / 36;
      int bl = rest >> 3, d = (rest >> 2) & 1, g = rest & 3;
      if (NB == 4 && gridDim.x == 512) {
        const int x = it & 7, k = it >> 3, team = x * 4 + k / 36;
        cc = k % 36; bl = team >> 3; g = (team >> 1) & 3; d = team & 1;
      }
      ssd_pre(p, l, bl, d, g, cc, smem);
    }
  }
}

__device__ void phase_chain(CP p, int g, int l, char* smem) {
  const int NB = p->NB;
  const int n_ssd = NB * 64, n_gla = NB * 32, n_lru = NB * 8;
  if (g == 0 && l < 3) {
    const int n_items = n_ssd + n_gla + n_lru;
    const int nidle = (int)gridDim.x - n_items;
    if (nidle >= 32) {
      if ((int)blockIdx.x >= n_items)
        for (int it = blockIdx.x - n_items; it < N_LAYER_TILES; it += nidle) convert_layer_item(p, l + 1, it, (float*)smem);
    } else {
      for (int it = blockIdx.x; it < N_LAYER_TILES; it += gridDim.x) convert_layer_item(p, l + 1, it, (float*)smem);
      __syncthreads();
    }
  }
  for (int item = blockIdx.x; item < n_ssd + n_gla + n_lru; item += gridDim.x) {
    int it = item;
    const bool xcd_map = (NB == 4) && (gridDim.x == 512);
    if (it < n_ssd) {
      int bl = it >> 6, hh = (it >> 1) & 31, d = it & 1;
      if (xcd_map) {
        const int x = it & 7, j = it >> 3, team = x * 4 + (j >> 3);
        bl = team >> 3; hh = ((team >> 1) & 3) * 8 + (j & 7); d = team & 1;
      }
      ssd_chain(p, l, bl, hh, d, smem);
    } else if (it < n_ssd + n_gla) {
      it -= n_ssd;
      int bl = it >> 5, hd = (it >> 3) & 3, d = (it >> 2) & 1, vs = it & 3;
      if (xcd_map) {
        const int x = it & 7, j = it >> 3, team = x * 4 + (j >> 2);
        bl = team >> 3; hd = (team >> 1) & 3; d = team & 1; vs = j & 3;
      }
      gla_chain(p, l, bl, hd, d, vs, smem);
    } else {
      it -= n_ssd + n_gla;
      lru_chain(p, it >> 3, (it >> 2) & 1, it & 3);
    }
    __syncthreads();
  }
}

__device__ __forceinline__ void ld16bf(const bf16_t* p, float (&o)[16]) {
  uint4 a = *(const uint4*)p, b = *(const uint4*)(p + 8);
  unsigned wv[8] = {a.x, a.y, a.z, a.w, b.x, b.y, b.z, b.w};
#pragma unroll
  for (int e = 0; e < 8; ++e) { o[2 * e] = lo2f(wv[e]); o[2 * e + 1] = hi2f(wv[e]); }
}
__device__ __forceinline__ void st16bf(bf16_t* p, const float (&v)[16]) {
  uint4 a, b;
  a.x = pack2(v[0], v[1]); a.y = pack2(v[2], v[3]); a.z = pack2(v[4], v[5]); a.w = pack2(v[6], v[7]);
  b.x = pack2(v[8], v[9]); b.y = pack2(v[10], v[11]); b.z = pack2(v[12], v[13]); b.w = pack2(v[14], v[15]);
  *(uint4*)p = a;
  *(uint4*)(p + 8) = b;
}
__device__ void phase_prep(CP p, int l) {
  const int tid = tid_opaque(), lane = tid & 63, w = tid >> 6;
  const int nrows = p->NB * TPB;
  for (int rr = blockIdx.x * 4 + w; rr < nrows; rr += gridDim.x * 4) {
    if (l == 3 && (rr % TPB) < 256) continue;
    const bf16_t* yr = p->y + (size_t)rr * NY;
    const bf16_t* ur = p->u + (size_t)rr * NU;
    bf16_t* ar = p->acat + (size_t)rr * 4096;
    const int c0 = lane * 16;
    float a[16], b2[16], gt[16];
    {
      const int bl = rr / TPB, pp = rr % TPB;
      const int ccf = (pp < 256) ? (pp >> 5) : 8 + ((pp - 256) >> 5);
      const int ccb = (pp < 256) ? 7 - (pp >> 5) : 8 + 63 - ((pp - 256) >> 5);
      const bf16_t* acr = p->acum + (size_t)rr * 2048;
      const float* hf = p->lruH + (size_t)((bl * 2 + 0) * 72 + ccf) * 1024 + c0;
      const float* hb = p->lruH + (size_t)((bl * 2 + 1) * 72 + ccb) * 1024 + c0;
      float af[16], abk[16];
      ld16bf(yr + c0, a); ld16bf(yr + 1024 + c0, b2); ld16bf(ur + U_LRUG + c0, gt);
      ld16bf(acr + c0, af); ld16bf(acr + 1024 + c0, abk);
#pragma unroll
      for (int e4 = 0; e4 < 4; ++e4) {
        float4 h0 = *(const float4*)(hf + e4 * 4), h1 = *(const float4*)(hb + e4 * 4);
        a[e4 * 4 + 0] += af[e4 * 4 + 0] * h0.x + b2[e4 * 4 + 0] + abk[e4 * 4 + 0] * h1.x;
        a[e4 * 4 + 1] += af[e4 * 4 + 1] * h0.y + b2[e4 * 4 + 1] + abk[e4 * 4 + 1] * h1.y;
        a[e4 * 4 + 2] += af[e4 * 4 + 2] * h0.z + b2[e4 * 4 + 2] + abk[e4 * 4 + 2] * h1.z;
        a[e4 * 4 + 3] += af[e4 * 4 + 3] * h0.w + b2[e4 * 4 + 3] + abk[e4 * 4 + 3] * h1.w;
      }
#pragma unroll
      for (int e = 0; e < 16; ++e) a[e] = a[e] * silu(gt[e]);
      st16bf(ar + c0, a);
    }
    ld16bf(yr + 2048 + c0, a); ld16bf(yr + 3072 + c0, b2); ld16bf(ur + U_GG + c0, gt);
    float ss = 0.f;
#pragma unroll
    for (int e = 0; e < 16; ++e) { a[e] += b2[e]; ss += a[e] * a[e]; }
#pragma unroll
    for (int o = 8; o >= 1; o >>= 1) ss += __shfl_xor(ss, o);
    float rinv = rsqrtf(ss * (1.f / 256.f) + EPSV);
    {
      const float* gn = p->gla_norm_g + l * 256 + (c0 & 255);
#pragma unroll
      for (int e = 0; e < 16; ++e) a[e] = a[e] * rinv * gn[e] * silu(gt[e]);
    }
    st16bf(ar + 1024 + c0, a);
    const int c1 = lane * 32;
    float v3[2][16];
    ss = 0.f;
#pragma unroll
    for (int hlf = 0; hlf < 2; ++hlf) {
      float xs[16];
      const float Dh = p->ssd_d[l * 32 + (lane >> 1)];
      ld16bf(yr + 4096 + c1 + hlf * 16, a); ld16bf(yr + 6144 + c1 + hlf * 16, b2); ld16bf(ur + U_Z + c1 + hlf * 16, gt);
      ld16bf(p->xc + (size_t)rr * XC_LD + 1024 + c1 + hlf * 16, xs);
#pragma unroll
      for (int e = 0; e < 16; ++e) { float v = (a[e] + b2[e] + Dh * xs[e]) * silu(gt[e]); v3[hlf][e] = v; ss += v * v; }
    }
#pragma unroll
    for (int o = 8; o >= 1; o >>= 1) ss += __shfl_xor(ss, o);
    rinv = rsqrtf(ss * (1.f / 512.f) + EPSV);
#pragma unroll
    for (int hlf = 0; hlf < 2; ++hlf) {
      const float* gn = p->ssd_norm_g + l * 2048 + c1 + hlf * 16;
#pragma unroll
      for (int e = 0; e < 16; ++e) v3[hlf][e] = v3[hlf][e] * rinv * gn[e];
      st16bf(ar + 2048 + c1 + hlf * 16, v3[hlf]);
    }
  }
}

__device__ void phase_merge(CP p, int l, bf16_t* smem) {
  const int tid = tid_opaque(), lane = tid & 63, w = tid >> 6, r = lane & 15, q = lane >> 4;
  const int MT = p->NB * TPB / 144, NT = 8;
  for (int tile = blockIdx.x; tile < MT * NT; tile += gridDim.x) {
    const int mt = tile % MT, nt = tile / MT;
    if (l == 3 && (mt & 15) == 0) continue;
    f32x4 mg[9][2];
#pragma unroll
    for (int i = 0; i < 9; ++i) { mg[i][0] = (f32x4){0.f, 0.f, 0.f, 0.f}; mg[i][1] = (f32x4){0.f, 0.f, 0.f, 0.f}; }
#pragma unroll 1
    for (int br = 0; br < 3; ++br) {
      f32x4 acc[9][2];
#pragma unroll
      for (int i = 0; i < 9; ++i) { acc[i][0] = (f32x4){0.f, 0.f, 0.f, 0.f}; acc[i][1] = (f32x4){0.f, 0.f, 0.f, 0.f}; }
      const bf16_t* A = p->acat + (br == 0 ? 0 : br == 1 ? 1024 : 2048);
      const bf16_t* Bt = (br == 0 ? p->wpaT + (size_t)l * 1024 * 1024 : br == 1 ? p->wpbT + (size_t)l * 1024 * 1024 : p->wpcT + (size_t)l * 1024 * 2048);
      const int K = (br == 2) ? 2048 : 1024;
      gemm_tile144<0>(A, 4096, Bt, K, K, mt * 144, nt * 128, acc, smem);
#pragma unroll
      for (int i = 0; i < 9; ++i) {
        const bf16_t* gp = p->u + (size_t)(mt * 144 + i * 16 + r) * NU + U_MG + br * 1024 + nt * 128 + w * 32 + q * 4;
#pragma unroll
        for (int j = 0; j < 2; ++j) {
          float4 gv = ld4bf(gp + j * 16);
          mg[i][j][0] += sigm(gv.x) * acc[i][j][0];
          mg[i][j][1] += sigm(gv.y) * acc[i][j][1];
          mg[i][j][2] += sigm(gv.z) * acc[i][j][2];
          mg[i][j][3] += sigm(gv.w) * acc[i][j][3];
        }
      }
    }
#pragma unroll
    for (int i = 0; i < 9; ++i) {
      bf16_t* rowp = p->h + (size_t)(mt * 144 + i * 16 + r) * 1024 + nt * 128 + w * 32 + q * 4;
#pragma unroll
      for (int j = 0; j < 2; ++j) {
        uint2 o2;
        o2.x = pack2(mg[i][j][0], mg[i][j][1]);
        o2.y = pack2(mg[i][j][2], mg[i][j][3]);
        *(uint2*)(rowp + j * 16) = o2;
      }
    }
  }
}

__device__ void phase_out(CP p, int l, bf16_t* smem) {
  const int tid = tid_opaque(), lane = tid & 63, w = tid >> 6, r = lane & 15, q = lane >> 4;
  const int MT = p->NB * TPB / 144, NT = 8;
  const bf16_t* Bt = p->woutT + (size_t)l * 1024 * 1024;
  for (int tile = blockIdx.x; tile < MT * NT; tile += gridDim.x) {
    const int mt = tile % MT, nt = tile / MT;
    if (l == 3 && (mt & 15) == 0) continue;
    f32x4 acc[9][2];
#pragma unroll
    for (int i = 0; i < 9; ++i) { acc[i][0] = (f32x4){0.f, 0.f, 0.f, 0.f}; acc[i][1] = (f32x4){0.f, 0.f, 0.f, 0.f}; }
    gemm_tile144<1>(p->h, 1024, Bt, 1024, 1024, mt * 144, nt * 128, acc, smem);
#pragma unroll
    for (int i = 0; i < 9; ++i) {
      const int row = mt * 144 + i * 16 + r;
      float* rowp = p->obuf + (size_t)row * 1024 + nt * 128 + w * 32 + q * 4;
      float ss = 0.f;
#pragma unroll
      for (int j = 0; j < 2; ++j) {
        *(float4*)(rowp + j * 16) = make_float4(acc[i][j][0], acc[i][j][1], acc[i][j][2], acc[i][j][3]);
        ss += acc[i][j][0] * acc[i][j][0] + acc[i][j][1] * acc[i][j][1] + acc[i][j][2] * acc[i][j][2] + acc[i][j][3] * acc[i][j][3];
      }
      ss += __shfl_xor(ss, 16);
      ss += __shfl_xor(ss, 32);
      if (q == 0) p->sspart[(size_t)row * 32 + nt * 4 + w] = ss;
    }
  }
}

#define XB_TMO      128
#define XB_XCNT(j)  (256  + 64 * (j))
#define XB_XSUB(j)  (1280 + 64 * (j))
#define XB_XGEN(j)  (2304 + 64 * (j))
#define XB_TOP      3328
#define XB_TOPGEN   3392
#define XCD_BAR_WORDS 3456
#define XB_SPIN_CAP (1u << 22)
#define LAS __attribute__((address_space(3)))
__device__ __forceinline__ unsigned xb_ld(unsigned* p)              { return __hip_atomic_load(p, __ATOMIC_RELAXED, __HIP_MEMORY_SCOPE_AGENT); }
__device__ __forceinline__ unsigned xb_add(unsigned* p, unsigned v) { return __hip_atomic_fetch_add(p, v, __ATOMIC_RELAXED, __HIP_MEMORY_SCOPE_AGENT); }
__device__ __forceinline__ unsigned xb_xcc_id() { return (unsigned)__builtin_amdgcn_s_getreg((3 << 11) | 20) & 0xFu; }
#define XB_SPIN(cond, bar) do { unsigned _sp = 0; while (cond) { __builtin_amdgcn_s_sleep(1); \
    if ((++_sp & 255u) == 0u) { if (xb_ld(&(bar)[XB_TMO])) break; if (_sp > XB_SPIN_CAP) { atomicAdd(&(bar)[XB_TMO], 1u); break; } } } } while (0)
struct XcdBarrier { unsigned* bar; unsigned x; volatile LAS unsigned* st; };
__device__ __forceinline__ XcdBarrier xcd_barrier_post(unsigned* bar, volatile LAS unsigned* st) {
  XcdBarrier b; b.bar = bar; b.x = xb_xcc_id(); b.st = st;
  if (threadIdx.x == 0) (void)xb_add(&bar[XB_XCNT(b.x)], 1u);
  return b;
}
__device__ __forceinline__ void xcd_barrier_complete(unsigned* bar, unsigned x, unsigned& nloc, unsigned& nx) {
  const unsigned G = gridDim.x * gridDim.y * gridDim.z;
  unsigned sum, cnt, mine, sp = 0u;
  for (;;) {
    sum = 0u; cnt = 0u; mine = 0u;
#pragma unroll
    for (unsigned j = 0; j < 16; ++j) { const unsigned c = xb_ld(&bar[XB_XCNT(j)]); sum += c; cnt += (c > 0u) ? 1u : 0u; mine = (j == x) ? c : mine; }
    if (sum == G) break;
    __builtin_amdgcn_s_sleep(1);
    if ((++sp & 255u) == 0u) { if (xb_ld(&bar[XB_TMO])) break; if (sp > XB_SPIN_CAP) { atomicAdd(&bar[XB_TMO], 1u); break; } }
  }
  nloc = mine > 0u ? mine : 1u; nx = cnt > 0u ? cnt : 1u;
}
__device__ __forceinline__ void xcd_barrier(const XcdBarrier& b) {
  asm volatile("s_waitcnt vmcnt(0)" ::: "memory");
  __syncthreads();
  if (threadIdx.x == 0) {
    unsigned* bar = b.bar;
    __builtin_amdgcn_s_waitcnt(0);
    unsigned nloc = b.st[0], nx = b.st[1];
    if (nloc == 0u) { xcd_barrier_complete(bar, b.x, nloc, nx); b.st[0] = nloc; b.st[1] = nx; }
    const unsigned old = xb_add(&bar[XB_XSUB(b.x)], 1u);
    const unsigned gen = old / nloc;
    if (old + 1u == (gen + 1u) * nloc) {
      __builtin_amdgcn_fence(__ATOMIC_RELEASE, "agent");
      asm volatile("s_waitcnt vmcnt(0)" ::: "memory");
      const unsigned og = xb_add(&bar[XB_TOP], 1u);
      const unsigned tg = og / nx;
      if (og + 1u == (tg + 1u) * nx) xb_add(&bar[XB_TOPGEN], 1u);
      else XB_SPIN(xb_ld(&bar[XB_TOPGEN]) == tg, bar);
      __builtin_amdgcn_fence(__ATOMIC_ACQUIRE, "agent");
      xb_add(&bar[XB_XGEN(b.x)], 1u);
      asm volatile("s_waitcnt vmcnt(0)" ::: "memory");
    } else {
      XB_SPIN(xb_ld(&bar[XB_XGEN(b.x)]) == gen, bar);
      __builtin_amdgcn_fence(__ATOMIC_ACQUIRE, "agent");
      asm volatile("s_waitcnt vmcnt(0)" ::: "memory");
    }
  }
  __syncthreads();
}

__global__ void __launch_bounds__(256, 2) mega(Params pv, int ph_begin, int ph_end) {
  __shared__ __attribute__((aligned(16))) char smem[SMEM_BYTES];
  cg::grid_group grid = cg::this_grid();
  volatile LAS unsigned* xst = (volatile LAS unsigned*)(smem + SMEM_BYTES - 16);
  if (threadIdx.x == 0) { xst[0] = 0u; xst[1] = 0u; }
  __syncthreads();
  XcdBarrier xb = xcd_barrier_post(pv.bar, xst);
  for (int ph = ph_begin; ph < ph_end; ++ph) {
    CP p = (CP)__builtin_amdgcn_kernarg_segment_ptr();
    asm volatile("" : "+s"(p));
    if (ph == 0) {
      phase_prologue(p, (float*)smem);
    } else {
      const int qq = ph - 1, g = qq / NPH_PER_GROUP, s = qq % NPH_PER_GROUP;
      if (s == 32) {
        phase_p1(p, g, 4);
      } else {
        const int l = s / 8, k = s % 8;
        switch (k) {
          case 0: phase_p1(p, g, l); break;
          case 1: phase_gemm_in(p, l, (bf16_t*)smem); break;
          case 2: phase_pre_a(p, l, smem); break;
          case 3: phase_pre_b(p, l, smem); break;
          case 4: phase_chain(p, g, l, smem); break;
          case 5: phase_prep(p, l); break;
          case 6: phase_merge(p, l, (bf16_t*)smem); break;
          default: phase_out(p, l, (bf16_t*)smem); break;
        }
      }
    }
    if (ph + 1 < ph_end) {
      if (ph == 0) grid.sync(); else xcd_barrier(xb);
    }
  }
}

static inline size_t align_up(size_t v, size_t a) { return (v + a - 1) / a * a; }

extern "C" void kernel_launch(void* const* d_in, const int* in_sizes, int n_in, void* d_out, int out_size, void* d_ws,
                              size_t ws_size, hipStream_t stream) {
  Params p{};
  const float** fp = (const float**)&p;
  for (int i = 0; i < 29; ++i) fp[i] = (const float*)d_in[i];
  p.out = (float*)d_out;
  char* ws = (char*)d_ws;
  size_t off = 0;
  auto take = [&](size_t bytes) { char* r = ws + off; off = align_up(off + bytes, 256); return r; };
  p.bar = (unsigned*)take((size_t)XCD_BAR_WORDS * 4);
  p.winT = (bf16_t*)take((size_t)4 * NU * 1024 * 2);
  p.wpaT = (bf16_t*)take((size_t)4 * 1024 * 1024 * 2);
  p.wpbT = (bf16_t*)take((size_t)4 * 1024 * 1024 * 2);
  p.wpcT = (bf16_t*)take((size_t)4 * 1024 * 2048 * 2);
  p.woutT = (bf16_t*)take((size_t)4 * 1024 * 1024 * 2);
  p.wrT = (bf16_t*)take((size_t)64 * 128 * 128 * 2);
  p.wiT = (bf16_t*)take((size_t)64 * 128 * 128 * 2);
  p.mod = (float*)take((size_t)4 * 17 * 3072 * 4);
  p.xctx = (float*)take((size_t)16 * 256 * 1024 * 4);
  const size_t fixed = off;
  int NB = 4;
  for (; NB > 1; NB >>= 1) {
    size_t rows = (size_t)NB * TPB;
    size_t need = rows * (1024 * 4 + 32 * 4 + 1024 * 2 + (size_t)NU * 2 + NY * 2 + 4096 * 2 + 2048 * 2 + 4096 * 2) +
                  (size_t)NB * (2 * 72 * 1024 * 12 + 2 * 32 * 2 * TPB * 4) + 16 * 256;
    if (fixed + need <= ws_size) break;
  }
  p.NB = NB;
  p.ngroups = 16 / NB;
  const size_t rows = (size_t)NB * TPB;
  p.obuf = (float*)take(rows * 1024 * 4);
  p.sspart = (float*)take(rows * 32 * 4);
  p.h = (bf16_t*)take(rows * 1024 * 2);
  p.spre = (char*)p.obuf;
  p.acat = (bf16_t*)take(rows * 4096 * 2);
  p.gpre = (char*)p.acat;
  p.u = (bf16_t*)take(rows * NU * 2);
  p.y = (bf16_t*)take(rows * NY * 2);
  p.acum = (bf16_t*)take(rows * 2048 * 2);
  p.xc = (bf16_t*)take(rows * 4096 * 2);
  p.lruE = (float*)take((size_t)NB * 2 * 72 * 1024 * 8);
  p.lruH = (float*)take((size_t)NB * 2 * 72 * 1024 * 4);
  p.cumdt = (float*)take((size_t)NB * 2 * 32 * 2 * TPB * 4);

  static int grid_blocks = 0;
  if (!grid_blocks) {
    int dev = 0, cus = 0, per_cu = 0;
    hipGetDevice(&dev);
    hipDeviceGetAttribute(&cus, hipDeviceAttributeMultiprocessorCount, dev);
    hipOccupancyMaxActiveBlocksPerMultiprocessor(&per_cu, (const void*)mega, 256, 0);
    if (per_cu > 2) per_cu = 2;
    if (per_cu < 1) per_cu = 1;
    grid_blocks = cus * per_cu;
  }
  hipMemsetAsync(p.bar, 0, (size_t)XCD_BAR_WORDS * 4, stream);
  const int nph = 1 + p.ngroups * NPH_PER_GROUP;
  int b = 0, e = nph;
  void* args[] = {&p, &b, &e};
  hipError_t err = hipLaunchCooperativeKernel((const void*)mega, dim3(grid_blocks), dim3(256), args, 0, stream);
  if (err != hipSuccess) fprintf(stderr, "cooperative launch failed: %s (grid %d)\n", hipGetErrorString(err), grid_blocks);
}
```

```cpp
#include <hip/hip_runtime.h>
#include <hip/hip_cooperative_groups.h>
#include <cstdio>
namespace cg = cooperative_groups;

typedef unsigned short bf16_t;
typedef short bf16x8 __attribute__((ext_vector_type(8)));
typedef float f32x4 __attribute__((ext_vector_type(4)));
typedef unsigned u32x4 __attribute__((ext_vector_type(4)));

#define DM 1024
#define TPB 2304
#define NU 13440
#define NIN 13408
#define SMEM_BYTES 73728
#define EPSV 1e-6f
#define NPH_PER_GROUP 33

#define U_LRUX 0
#define U_LRUG 1024
#define U_Q 2048
#define U_K 2560
#define U_V 3072
#define U_GG 4096
#define U_LOW 5120
#define U_Z 5152
#define U_XBC 7200
#define U_DT 10272
#define U_MG 10336
#define NY 8192

struct Params {
  const float *x, *c, *ctx, *c_ctx, *ada_w, *ada_b, *pre_g, *post_g, *w_in, *conv_a_w, *conv_a_b,
      *lru_wr, *lru_br, *lru_wi, *lru_bi, *lru_lam, *gla_up, *gla_b, *gla_norm_g, *conv_c_w, *conv_c_b,
      *ssd_a_log, *ssd_dt_bias, *ssd_d, *ssd_norm_g, *w_pa, *w_pb, *w_pc, *w_out;
  float* out;
  bf16_t *winT, *wpaT, *wpbT, *wpcT, *woutT, *wrT, *wiT;
  float *mod, *xctx, *obuf, *sspart;
  bf16_t *h, *u, *y, *acat, *acum, *xc;
  float *lruE, *lruH, *cumdt;
  char *gpre, *spre;
  unsigned* bar;
  int NB, ngroups;
};

typedef const Params __attribute__((address_space(4))) * CP;
__device__ __forceinline__ int tid_opaque() {
  int t = threadIdx.x;
  asm volatile("" : "+v"(t));
  return t;
}
typedef __bf16 bf16x2_t __attribute__((ext_vector_type(2)));
typedef float f32x2_t __attribute__((ext_vector_type(2)));
__device__ __forceinline__ unsigned pack2(float a, float b) {
  f32x2_t v = {a, b};
  bf16x2_t r = __builtin_convertvector(v, bf16x2_t);
  return __builtin_bit_cast(unsigned, r);
}
__device__ __forceinline__ bf16_t f2bf(float f) { return (bf16_t)(pack2(f, f) & 0xffffu); }
__device__ __forceinline__ float bf2f(bf16_t h) { return __uint_as_float(((unsigned)h) << 16); }
__device__ __forceinline__ float lo2f(unsigned w) { return __uint_as_float(w << 16); }
__device__ __forceinline__ float hi2f(unsigned w) { return __uint_as_float(w & 0xffff0000u); }
__device__ __forceinline__ float sigm(float x) { return __builtin_amdgcn_rcpf(1.f + __expf(-x)); }
__device__ __forceinline__ float silu(float x) { return x * __builtin_amdgcn_rcpf(1.f + __expf(-x)); }
__device__ __forceinline__ float softplus(float x) { return fmaxf(x, 0.f) + __logf(1.f + __expf(-fabsf(x))); }
__device__ __forceinline__ f32x4 mfma16(bf16x8 a, bf16x8 b, f32x4 c) { return __builtin_amdgcn_mfma_f32_16x16x32_bf16(a, b, c, 0, 0, 0); }
__device__ __forceinline__ int spos(int l, int t) { return (l & 1) ? ((t & 63) * 32 + (t >> 6)) : t; }

__device__ __forceinline__ void gemm_tile(const bf16_t* __restrict__ A, int lda, const bf16_t* __restrict__ Bt, int ldb, int K,
                                          int m0, int n0, f32x4 (&acc)[4][4], bf16_t* smem) {
  const int tid = tid_opaque(), lane = tid & 63, w = tid >> 6, wr = w >> 1, wc = w & 1, r = lane & 15, q = lane >> 4;
  char* sm = (char*)smem;
  const int srow = w * 8 + (lane >> 3);
  const int scol = ((lane & 7) ^ (((w & 1) << 2) + (lane >> 4))) * 8;
  const bf16_t* gA = A + (size_t)(m0 + srow) * lda + scol;
  const bf16_t* gB = Bt + (size_t)(n0 + srow) * ldb + scol;
  const int fsw = (r >> 1) & 7;
  const int nt = K >> 6;
#define GT_STAGE(buf, kt)                                                                                              \
  do {                                                                                                                 \
    _Pragma("unroll") for (int i = 0; i < 4; ++i) {                                                                    \
      __builtin_amdgcn_global_load_lds((const unsigned*)(gA + (size_t)(32 * i) * lda + (kt) * 64),                     \
                                       (unsigned*)(sm + (buf) * 32768 + i * 4096 + w * 1024), 16, 0, 0);               \
      __builtin_amdgcn_global_load_lds((const unsigned*)(gB + (size_t)(32 * i) * ldb + (kt) * 64),                     \
                                       (unsigned*)(sm + (buf) * 32768 + 16384 + i * 4096 + w * 1024), 16, 0, 0);       \
    }                                                                                                                  \
  } while (0)
  GT_STAGE(0, 0);
  asm volatile("s_waitcnt vmcnt(0)" ::: "memory");
  __syncthreads();
  for (int t = 0; t < nt; ++t) {
    const int cur = t & 1;
    if (t + 1 < nt) GT_STAGE(cur ^ 1, t + 1);
    const char* sA = sm + cur * 32768;
    const char* sB = sA + 16384;
#pragma unroll
    for (int ks = 0; ks < 2; ++ks) {
      bf16x8 af[4], bfr[4];
      const int co = ((ks * 4 + q) ^ fsw) * 16;
#pragma unroll
      for (int i = 0; i < 4; ++i) af[i] = *(const bf16x8*)(sA + (wr * 64 + i * 16 + r) * 128 + co);
#pragma unroll
      for (int j = 0; j < 4; ++j) bfr[j] = *(const bf16x8*)(sB + (wc * 64 + j * 16 + r) * 128 + co);
      __builtin_amdgcn_s_setprio(1);
#pragma unroll
      for (int i = 0; i < 4; ++i)
#pragma unroll
        for (int j = 0; j < 4; ++j) acc[i][j] = mfma16(bfr[j], af[i], acc[i][j]);
      __builtin_amdgcn_s_setprio(0);
    }
    asm volatile("s_waitcnt vmcnt(0)" ::: "memory");
    __syncthreads();
  }
#undef GT_STAGE
}

__device__ __forceinline__ void zero_acc(f32x4 (&acc)[4][4]) {
#pragma unroll
  for (int i = 0; i < 4; ++i)
#pragma unroll
    for (int j = 0; j < 4; ++j) acc[i][j] = (f32x4){0.f, 0.f, 0.f, 0.f};
}

template <int DB>
__device__ __forceinline__ void gemm_tile144(const bf16_t* __restrict__ A, int lda, const bf16_t* __restrict__ Bt, int ldb, int K,
                                             int m0, int n0, f32x4 (&acc)[9][2], bf16_t* smem) {
  const int tid = tid_opaque(), lane = tid & 63, w = tid >> 6, r = lane & 15, q = lane >> 4;
  char* sm = (char*)smem;
  const int srow = w * 8 + (lane >> 3);
  const int scol = ((lane & 7) ^ (((w & 1) << 2) + (lane >> 4))) * 8;
  const bf16_t* gA = A + (size_t)(m0 + srow) * lda + scol;
  const bf16_t* gB = Bt + (size_t)(n0 + srow) * ldb + scol;
  const int fsw = (r >> 1) & 7;
  const int nt = K >> 6;
#define GT_STAGE(buf, kt)                                                                                              \
  do {                                                                                                                 \
    _Pragma("unroll") for (int i = 0; i < 5; ++i) {                                                                    \
      if (i < 4 || w < 2)                                                                                              \
        __builtin_amdgcn_global_load_lds((const unsigned*)(gA + (size_t)(32 * i) * lda + (kt) * 64),                   \
                                         (unsigned*)(sm + (buf) * 34816 + i * 4096 + w * 1024), 16, 0, 0);             \
    }                                                                                                                  \
    _Pragma("unroll") for (int i = 0; i < 4; ++i) {                                                                    \
      __builtin_amdgcn_global_load_lds((const unsigned*)(gB + (size_t)(32 * i) * ldb + (kt) * 64),                     \
                                       (unsigned*)(sm + (buf) * 34816 + 18432 + i * 4096 + w * 1024), 16, 0, 0);       \
    }                                                                                                                  \
  } while (0)
  GT_STAGE(0, 0);
  asm volatile("s_waitcnt vmcnt(0)" ::: "memory");
  __syncthreads();
  for (int t = 0; t < nt; ++t) {
    const int cur = t & 1;
    if (t + 1 < nt) GT_STAGE(cur ^ 1, t + 1);
    const char* sA = sm + cur * 34816;
    const char* sB = sA + 18432;
    if (DB) {
      bf16x8 af[2][9], bfr[2][2];
#pragma unroll
      for (int ks = 0; ks < 2; ++ks) {
        const int co = ((ks * 4 + q) ^ fsw) * 16;
#pragma unroll
        for (int j = 0; j < 2; ++j) bfr[ks][j] = *(const bf16x8*)(sB + (w * 32 + j * 16 + r) * 128 + co);
#pragma unroll
        for (int i = 0; i < 9; ++i) af[ks][i] = *(const bf16x8*)(sA + (i * 16 + r) * 128 + co);
      }
      __builtin_amdgcn_s_setprio(1);
#pragma unroll
      for (int ks = 0; ks < 2; ++ks)
#pragma unroll
        for (int i = 0; i < 9; ++i)
#pragma unroll
          for (int j = 0; j < 2; ++j) acc[i][j] = mfma16(bfr[ks][j], af[ks][i], acc[i][j]);
      __builtin_amdgcn_s_setprio(0);
    } else {
#pragma unroll
      for (int ks = 0; ks < 2; ++ks) {
        const int co = ((ks * 4 + q) ^ fsw) * 16;
        bf16x8 af[9], bfr[2];
#pragma unroll
        for (int j = 0; j < 2; ++j) bfr[j] = *(const bf16x8*)(sB + (w * 32 + j * 16 + r) * 128 + co);
#pragma unroll
        for (int i = 0; i < 9; ++i) af[i] = *(const bf16x8*)(sA + (i * 16 + r) * 128 + co);
        __builtin_amdgcn_s_setprio(1);
#pragma unroll
        for (int i = 0; i < 9; ++i)
#pragma unroll
          for (int j = 0; j < 2; ++j) acc[i][j] = mfma16(bfr[j], af[i], acc[i][j]);
        __builtin_amdgcn_s_setprio(0);
      }
    }
    asm volatile("s_waitcnt vmcnt(0)" ::: "memory");
    __syncthreads();
  }
#undef GT_STAGE
}

__device__ void transpose_tile(const float* __restrict__ src, int ldsrc, int nvalid, bf16_t* __restrict__ dst, int lddst,
                               int k0, int n0, float* tile) {
  const int tid = tid_opaque(), c = tid & 63, r4 = tid >> 6;
  __syncthreads();
  {
    const int n = n0 + c;
    const int nc = (n < nvalid) ? n : (nvalid - 1);
    float v[16];
#pragma unroll
    for (int i = 0; i < 16; ++i) v[i] = src[(size_t)(k0 + i * 4 + r4) * ldsrc + nc];
#pragma unroll
    for (int i = 0; i < 16; ++i) tile[(i * 4 + r4) * 65 + c] = (n < nvalid) ? v[i] : 0.f;
  }
  __syncthreads();
#pragma unroll
  for (int it = 0; it < 2; ++it) {
    const int n = (tid >> 3) + 32 * it, kc = (tid & 7) * 8;
    u32x4 o;
#pragma unroll
    for (int e = 0; e < 4; ++e) o[e] = pack2(tile[(kc + 2 * e) * 65 + n], tile[(kc + 2 * e + 1) * 65 + n]);
    *(u32x4*)(dst + (size_t)(n0 + n) * lddst + k0 + kc) = o;
  }
}

#define N_LAYER_TILES 4640
__device__ void convert_layer_item(CP p, int l, int it, float* smf) {
  if (it < 3360) {
    int kt = it / 210, nt = it % 210;
    transpose_tile(p->w_in + (size_t)l * 1024 * NIN, NIN, NIN, p->winT + (size_t)l * NU * 1024, 1024, kt * 64, nt * 64, smf);
    return;
  }
  it -= 3360;
  if (it < 768) {
    int which = it / 256, rem = it % 256, kt = rem / 16, nt = rem % 16;
    const float* src = (which == 0 ? p->w_pa : which == 1 ? p->w_pb : p->w_out) + (size_t)l * 1024 * 1024;
    bf16_t* dst = (which == 0 ? p->wpaT : which == 1 ? p->wpbT : p->woutT) + (size_t)l * 1024 * 1024;
    transpose_tile(src, 1024, 1024, dst, 1024, kt * 64, nt * 64, smf);
    return;
  }
  it -= 768;
  {
    int kt = it / 16, nt = it % 16;
    transpose_tile(p->w_pc + (size_t)l * 2048 * 1024, 1024, 1024, p->wpcT + (size_t)l * 1024 * 2048, 2048, kt * 64, nt * 64, smf);
  }
}

__device__ void phase_prologue(CP p, float* smf) {
  const int tid = tid_opaque();
  const int NMOD = 48, N_LRU = 64 * 4;
  const int total = NMOD + 2 * N_LRU + N_LAYER_TILES;
  for (int item = blockIdx.x; item < total; item += gridDim.x) {
    int it = item;
    if (it < NMOD) {
      const int l = it / 12, nch = it % 12;
      __syncthreads();
      for (int i = tid; i < 17 * 1024; i += 256) {
        int bb = i >> 10, k = i & 1023;
        float cv = (bb < 16) ? p->c[bb * 1024 + k] : p->c_ctx[k];
        smf[i] = silu(cv);
      }
      __syncthreads();
      const int n = nch * 256 + tid;
      float acc[17];
      const float bias = p->ada_b[l * 3072 + n];
#pragma unroll
      for (int bb = 0; bb < 17; ++bb) acc[bb] = bias;
      const float* wp = p->ada_w + (size_t)l * 1024 * 3072 + n;
#pragma unroll 4
      for (int k = 0; k < 1024; ++k) {
        float wv = wp[(size_t)k * 3072];
#pragma unroll
        for (int bb = 0; bb < 17; ++bb) acc[bb] += smf[bb * 1024 + k] * wv;
      }
#pragma unroll
      for (int bb = 0; bb < 17; ++bb) p->mod[((size_t)l * 17 + bb) * 3072 + n] = acc[bb];
      continue;
    }
    it -= NMOD;
    if (it < 2 * N_LRU) {
      int which = it / N_LRU, rem = it % N_LRU, m = rem / 4, kt = (rem % 4) / 2, nt = rem % 2;
      const float* src = (which == 0 ? p->lru_wr : p->lru_wi) + (size_t)m * 128 * 128;
      bf16_t* dst = (which == 0 ? p->wrT : p->wiT) + (size_t)m * 128 * 128;
      transpose_tile(src, 128, 128, dst, 128, kt * 64, nt * 64, smf);
      continue;
    }
    it -= 2 * N_LRU;
    convert_layer_item(p, 0, it, smf);
  }
}

__device__ void phase_p1(CP p, int g, int l) {
  const int tid = tid_opaque(), lane = tid & 63, w = tid >> 6;
  const int nrows = p->NB * TPB;
  for (int rr = blockIdx.x * 4 + w; rr < nrows; rr += gridDim.x * 4) {
    const int bl = rr / TPB, pp = rr % TPB, b = g * p->NB + bl;
    const float* xin;
    float* xres;
    int orow, hrow, bb;
    if (pp < 256) {
      if (l == 4) continue;
      size_t off = ((size_t)b * 256 + pp) * 1024;
      xin = (l <= 1 ? p->ctx : p->xctx) + off;
      xres = p->xctx + off;
      orow = hrow = bl * TPB + pp;
      bb = 16;
    } else {
      int t = pp - 256;
      size_t off = ((size_t)b * 2048 + t) * 1024;
      xin = (l <= 1 ? p->x : p->out) + off;
      xres = p->out + off;
      orow = bl * TPB + 256 + spos(l - 1, t);
      hrow = bl * TPB + 256 + spos(l, t);
      bb = b;
    }
    float4 v[4];
#pragma unroll
    for (int i = 0; i < 4; ++i) v[i] = *(const float4*)(xin + (i * 64 + lane) * 4);
    if (l > 0) {
      float ss = (lane < 32) ? p->sspart[(size_t)orow * 32 + lane] : 0.f;
#pragma unroll
      for (int o = 16; o >= 1; o >>= 1) ss += __shfl_xor(ss, o);
      ss = __shfl(ss, 0);
      const float rinv = rsqrtf(ss * (1.f / 1024.f) + EPSV);
      const float* gate = p->mod + ((size_t)(l - 1) * 17 + bb) * 3072 + 2048;
      const float* pg = p->post_g + (l - 1) * 1024;
      const float* orp = p->obuf + (size_t)orow * 1024;
#pragma unroll
      for (int i = 0; i < 4; ++i) {
        int col = (i * 64 + lane) * 4;
        float4 o4 = *(const float4*)(orp + col), g4 = *(const float4*)(gate + col), p4 = *(const float4*)(pg + col);
        v[i].x += g4.x * (o4.x * rinv * p4.x);
        v[i].y += g4.y * (o4.y * rinv * p4.y);
        v[i].z += g4.z * (o4.z * rinv * p4.z);
        v[i].w += g4.w * (o4.w * rinv * p4.w);
      }
    }
#pragma unroll
    for (int i = 0; i < 4; ++i) if (l > 0) *(float4*)(xres + (i * 64 + lane) * 4) = v[i];
    if (l < 4) {
      float sq = 0.f;
#pragma unroll
      for (int i = 0; i < 4; ++i) sq += v[i].x * v[i].x + v[i].y * v[i].y + v[i].z * v[i].z + v[i].w * v[i].w;
#pragma unroll
      for (int o = 32; o >= 1; o >>= 1) sq += __shfl_xor(sq, o);
      const float rinv = rsqrtf(sq * (1.f / 1024.f) + EPSV);
      const float* md = p->mod + ((size_t)l * 17 + bb) * 3072;
      const float* pg = p->pre_g + l * 1024;
      bf16_t* hr = p->h + (size_t)hrow * 1024;
#pragma unroll
      for (int i = 0; i < 4; ++i) {
        int col = (i * 64 + lane) * 4;
        float4 sh = *(const float4*)(md + col), sc = *(const float4*)(md + 1024 + col), p4 = *(const float4*)(pg + col);
        float a0 = (v[i].x * rinv * p4.x) * (1.f + sc.x) + sh.x;
        float a1 = (v[i].y * rinv * p4.y) * (1.f + sc.y) + sh.y;
        float a2 = (v[i].z * rinv * p4.z) * (1.f + sc.z) + sh.z;
        float a3 = (v[i].w * rinv * p4.w) * (1.f + sc.w) + sh.w;
        uint2 o2;
        o2.x = pack2(a0, a1);
        o2.y = pack2(a2, a3);
        *(uint2*)(hr + col) = o2;
      }
    }
  }
}

__device__ __forceinline__ int gi_scan_tile(int i) {
  return (i < 8) ? i : (i < 24) ? 16 + (i - 8) : (i < 25) ? 40 : 56 + (i - 25);
}
__device__ __forceinline__ int gi_fin_tile(int i) {
  return (i < 8) ? 8 + i : (i < 16) ? 32 + (i - 8) : (i < 31) ? 41 + (i - 16) : 81 + (i - 31);
}
struct GiTile { int mt, nt; };
__device__ __forceinline__ GiTile gi_decode(int idx, int MT, bool last_layer) {
  GiTile t;
  if (!last_layer) { t.mt = idx % MT; t.nt = idx / MT; return t; }
  const int nscan = 50 * MT;
  if (idx < nscan) { t.mt = idx % MT; t.nt = gi_scan_tile(idx / MT); return t; }
  const int j = idx - nscan, MTL = MT - MT / 9;
  const int mi = j % MTL;
  t.mt = (mi / 16) * 18 + 2 + (mi % 16);
  t.nt = gi_fin_tile(j / MTL);
  return t;
}
__device__ void phase_gemm_in(CP p, int l, bf16_t* smem) {
  const int tid = tid_opaque(), lane = tid & 63, w = tid >> 6, wr = w >> 1, wc = w & 1, r = lane & 15, q = lane >> 4;
  const bool lastl = (l == 3);
  const int MT = p->NB * TPB / 128, NT = NU / 128, ntiles = lastl ? 50 * MT + 55 * (MT - MT / 9) : MT * NT;
  const bf16_t* A = p->h;
  const bf16_t* Bt = p->winT + (size_t)l * NU * 1024;
  char* sm = (char*)smem;
  const int srow = w * 8 + (lane >> 3);
  const int scol = ((lane & 7) ^ (((w & 1) << 2) + (lane >> 4))) * 8;
  const int fsw = (r >> 1) & 7;
  int tile = blockIdx.x;
  if (tile >= ntiles) return;
#define GI_STAGE(buf, gA, gB, kt)                                                                                      \
  do {                                                                                                                 \
    _Pragma("unroll") for (int i = 0; i < 4; ++i) {                                                                    \
      __builtin_amdgcn_global_load_lds((const unsigned*)((gA) + (size_t)(32 * i) * 1024 + (kt) * 64),                  \
                                       (unsigned*)(sm + (buf) * 32768 + i * 4096 + w * 1024), 16, 0, 0);               \
      __builtin_amdgcn_global_load_lds((const unsigned*)((gB) + (size_t)(32 * i) * 1024 + (kt) * 64),                  \
                                       (unsigned*)(sm + (buf) * 32768 + 16384 + i * 4096 + w * 1024), 16, 0, 0);       \
    }                                                                                                                  \
  } while (0)
#define GI_READ(A0, B0, A1, B1, buf)                                                                                   \
    do {                                                                                                               \
      const char* sA_ = sm + (buf) * 32768;                                                                            \
      const char* sB_ = sA_ + 16384;                                                                                   \
      const int c0_ = ((0 * 4 + q) ^ fsw) * 16, c1_ = ((1 * 4 + q) ^ fsw) * 16;                                        \
      _Pragma("unroll") for (int i = 0; i < 4; ++i) A0[i] = *(const bf16x8*)(sA_ + (wr * 64 + i * 16 + r) * 128 + c0_); \
      _Pragma("unroll") for (int j = 0; j < 4; ++j) B0[j] = *(const bf16x8*)(sB_ + (wc * 64 + j * 16 + r) * 128 + c0_); \
      _Pragma("unroll") for (int i = 0; i < 4; ++i) A1[i] = *(const bf16x8*)(sA_ + (wr * 64 + i * 16 + r) * 128 + c1_); \
      _Pragma("unroll") for (int j = 0; j < 4; ++j) B1[j] = *(const bf16x8*)(sB_ + (wc * 64 + j * 16 + r) * 128 + c1_); \
    } while (0)
#define GI_MMA(AF, BF)                                                                                                 \
    do {                                                                                                               \
      _Pragma("unroll") for (int i = 0; i < 4; ++i)                                                                    \
        _Pragma("unroll") for (int j = 0; j < 4; ++j) acc[i][j] = mfma16(BF[j], AF[i], acc[i][j]);                     \
    } while (0)
#define GI_RAWBAR() do { asm volatile("s_waitcnt lgkmcnt(0)" ::: "memory"); __builtin_amdgcn_s_barrier(); asm volatile("" ::: "memory"); } while (0)
  GiTile tc = gi_decode(tile, MT, lastl);
  const bf16_t* gA = A + (size_t)(tc.mt * 128 + srow) * 1024 + scol;
  const bf16_t* gB = Bt + (size_t)(tc.nt * 128 + srow) * 1024 + scol;
  GI_STAGE(0, gA, gB, 0);
  GI_STAGE(1, gA, gB, 1);
  while (tile < ntiles) {
    const int mt = tc.mt, nt = tc.nt;
    const int next = tile + gridDim.x;
    const bool nvalid = next < ntiles;
    const GiTile tn = gi_decode(nvalid ? next : tile, MT, lastl);
    const bf16_t* gAn = A + (size_t)(tn.mt * 128 + srow) * 1024 + scol;
    const bf16_t* gBn = Bt + (size_t)(tn.nt * 128 + srow) * 1024 + scol;
    f32x4 acc[4][4];
    zero_acc(acc);
    bf16x8 af0[4], bf0[4], af1a[4], bf1a[4], af1b[4], bf1b[4];
    for (int t2 = 0; t2 < 8; ++t2) {
      if (t2 == 0) asm volatile("s_waitcnt vmcnt(0)" ::: "memory");
      else asm volatile("s_waitcnt vmcnt(8)" ::: "memory");
      GI_RAWBAR();
      GI_READ(af0, bf0, af1a, bf1a, 0);
      __builtin_amdgcn_s_setprio(1);
      if (t2 > 0) GI_MMA(af1b, bf1b);
      __builtin_amdgcn_s_setprio(0);
      GI_RAWBAR();
      if (t2 < 7) GI_STAGE(0, gA, gB, 2 * t2 + 2); else GI_STAGE(0, gAn, gBn, 0);
      __builtin_amdgcn_s_setprio(1);
      GI_MMA(af0, bf0);
      __builtin_amdgcn_s_setprio(0);
      asm volatile("s_waitcnt vmcnt(8)" ::: "memory");
      GI_RAWBAR();
      GI_READ(af0, bf0, af1b, bf1b, 1);
      __builtin_amdgcn_s_setprio(1);
      GI_MMA(af1a, bf1a);
      __builtin_amdgcn_s_setprio(0);
      GI_RAWBAR();
      if (t2 < 7) GI_STAGE(1, gA, gB, 2 * t2 + 3); else GI_STAGE(1, gAn, gBn, 1);
      __builtin_amdgcn_s_setprio(1);
      GI_MMA(af0, bf0);
      __builtin_amdgcn_s_setprio(0);
    }
    GI_MMA(af1b, bf1b);
#pragma unroll
    for (int i = 0; i < 4; ++i) {
      bf16_t* rowp = p->u + (size_t)(mt * 128 + wr * 64 + i * 16 + r) * NU + nt * 128 + wc * 64 + q * 4;
#pragma unroll
      for (int j = 0; j < 4; ++j) {
        uint2 o2;
        o2.x = pack2(acc[i][j][0], acc[i][j][1]);
        o2.y = pack2(acc[i][j][2], acc[i][j][3]);
        *(uint2*)(rowp + j * 16) = o2;
      }
    }
    tile = next;
    tc = tn;
    gA = gAn;
    gB = gBn;
  }
  asm volatile("s_waitcnt vmcnt(0)" ::: "memory");
  __syncthreads();
#undef GI_STAGE
#undef GI_READ
#undef GI_MMA
#undef GI_RAWBAR
}

__device__ __forceinline__ float4 ld4bf(const bf16_t* p) {
  uint2 w = *(const uint2*)p;
  return make_float4(lo2f(w.x), hi2f(w.x), lo2f(w.y), hi2f(w.y));
}
#define XC_LD 4096
__device__ __forceinline__ void ld8bf(const bf16_t* p, float (&o)[8]) {
  u32x4 a = *(const u32x4*)p;
#pragma unroll
  for (int e = 0; e < 4; ++e) { o[2 * e] = lo2f(a[e]); o[2 * e + 1] = hi2f(a[e]); }
}
__device__ void conv_block(CP p, int l, int bidx, int L) {
  const int idx = bidx * 256 + tid_opaque();
  const int ch = idx & 511, row4 = (idx >> 9) * 4;
  const int bl = row4 / TPB, pp = row4 % TPB;
  int lo, hi;
  if (pp < 256) { lo = 0; hi = 256; } else { int j = pp - 256; lo = 256 + j - (j % L); hi = lo + L; }
  const int c8 = ch * 8;
  int col; const float* wp; const float* bp; int wld; bool act;
  if (c8 < 1024) { col = U_LRUX + c8; wp = p->conv_a_w + (size_t)l * 4 * 1024 + c8; bp = p->conv_a_b + l * 1024 + c8; wld = 1024; act = false; }
  else { int cc = c8 - 1024; col = U_XBC + cc; wp = p->conv_c_w + (size_t)l * 4 * 3072 + cc; bp = p->conv_c_b + l * 3072 + cc; wld = 3072; act = true; }
  const bf16_t* base = p->u + (size_t)(bl * TPB) * NU + col;
  u32x4 raw[7];
#pragma unroll
  for (int k = 0; k < 7; ++k) {
    int rk = pp + k - 1;
    rk = rk < lo ? lo : (rk >= hi ? hi - 1 : rk);
    raw[k] = *(const u32x4*)(base + (size_t)rk * NU);
  }
  float wv[4][8], bsv[8];
  {
    const float4 b0 = *(const float4*)bp, b1 = *(const float4*)(bp + 4);
    bsv[0] = b0.x; bsv[1] = b0.y; bsv[2] = b0.z; bsv[3] = b0.w; bsv[4] = b1.x; bsv[5] = b1.y; bsv[6] = b1.z; bsv[7] = b1.w;
#pragma unroll
    for (int k = 0; k < 4; ++k) {
      const float4 w0 = *(const float4*)(wp + k * wld), w1 = *(const float4*)(wp + k * wld + 4);
      wv[k][0] = w0.x; wv[k][1] = w0.y; wv[k][2] = w0.z; wv[k][3] = w0.w; wv[k][4] = w1.x; wv[k][5] = w1.y; wv[k][6] = w1.z; wv[k][7] = w1.w;
    }
  }
  float xv[7][8];
#pragma unroll
  for (int k = 0; k < 7; ++k) {
    const int rk = pp + k - 1;
    const bool ok = (rk >= lo) && (rk < hi);
#pragma unroll
    for (int e = 0; e < 4; ++e) { xv[k][2 * e] = ok ? lo2f(raw[k][e]) : 0.f; xv[k][2 * e + 1] = ok ? hi2f(raw[k][e]) : 0.f; }
  }
#pragma unroll
  for (int t = 0; t < 4; ++t) {
    float acc[8];
#pragma unroll
    for (int e = 0; e < 8; ++e) {
      float a = bsv[e];
#pragma unroll
      for (int k = 0; k < 4; ++k) a += wv[k][e] * xv[t + k][e];
      acc[e] = act ? silu(a) : a;
    }
    u32x4 o;
    o[0] = pack2(acc[0], acc[1]); o[1] = pack2(acc[2], acc[3]); o[2] = pack2(acc[4], acc[5]); o[3] = pack2(acc[6], acc[7]);
    *(u32x4*)(p->xc + (size_t)(row4 + t) * XC_LD + c8) = o;
  }
}

template <int CS>
__device__ __forceinline__ int chunk_row0(int cc, int d) {
  const int nctx = 256 / CS, nlat = 2048 / CS;
  if (cc < nctx) return (d ? nctx - 1 - cc : cc) * CS;
  const int c = cc - nctx;
  return 256 + (d ? nlat - 1 - c : c) * CS;
}

typedef short s16x4 __attribute__((ext_vector_type(4)));
__device__ __forceinline__ bf16x8 tr_frag(const bf16_t* X, int ld, int s0, int c0, int r) {
  const bf16_t* a = X + (s0 + (r >> 2)) * ld + c0 + 4 * (r & 3);
  s16x4 lo = __builtin_amdgcn_ds_read_tr16_b64_v4i16((s16x4 __attribute__((address_space(3)))*)a);
  s16x4 hi = __builtin_amdgcn_ds_read_tr16_b64_v4i16((s16x4 __attribute__((address_space(3)))*)(a + 4 * ld));
  bf16x8 o;
  o[0] = lo[0]; o[1] = lo[1]; o[2] = lo[2]; o[3] = lo[3]; o[4] = hi[0]; o[5] = hi[1]; o[6] = hi[2]; o[7] = hi[3];
  return o;
}
__device__ __forceinline__ int kperm_off(int ch, int h) {
  const int b = ch >> 2, c = ch & 3;
  return b * 32 + ((c < 2) ? (16 * c + 8 * h) : (16 * (c - 2) + 4 + 8 * h));
}
#define GPRE_BYTES 41472
#define SPRE_BYTES 40960

__device__ void gla_pre(CP p, int l, int bl, int d, int hd, int cc2, char* smem) {
  const int tid = tid_opaque(), lane = tid & 63, w = tid >> 6, r = lane & 15, q = lane >> 4;
  bf16_t* sQe = (bf16_t*)smem;
  bf16_t* sKe = sQe + 64 * 136;
  bf16_t* sKeT = sKe + 64 * 136;
  float* sLow = (float*)(sKeT + 128 * 72);
  float* sTot = sLow + 64 * 16;
  float* sEb = sTot + 256;
  const int kk = tid & 127, half = tid >> 7;
  float up[16];
#pragma unroll
  for (int rr = 0; rr < 16; ++rr) up[rr] = p->gla_up[((size_t)(l * 2 + d) * 16 + rr) * 512 + hd * 128 + kk];
  const float zb = p->gla_b[(l * 2 + d) * 512 + hd * 128 + kk];
  const float qscale = 0.08838834764831845f;
  const bf16_t* ub = p->u + (size_t)bl * TPB * NU;
  u32x4 pq[4], pk[4];
  uint2 plw;
  {
    const int r0c = chunk_row0<64>(cc2 * 2, d);
#pragma unroll
    for (int it = 0; it < 4; ++it) {
      int cid = tid + 256 * it, t = cid >> 4, ch = cid & 15;
      const bf16_t* rp = ub + (size_t)(r0c + (d ? 63 - t : t)) * NU + U_Q + hd * 128 + ch * 8;
      pq[it] = *(const u32x4*)rp;
      pk[it] = *(const u32x4*)(rp + 512);
    }
    int t = tid >> 2, r0 = (tid & 3) * 4;
    plw = *(const uint2*)(ub + (size_t)(r0c + (d ? 63 - t : t)) * NU + U_LOW + d * 16 + r0);
  }
  for (int ci = 0; ci < 2; ++ci) {
  const int cc = cc2 * 2 + ci;
  char* blk = p->gpre + (size_t)((((bl * 2 + d) * 4 + hd) * 36) + cc) * GPRE_BYTES;
  __syncthreads();
  {
#pragma unroll
    for (int it = 0; it < 4; ++it) {
      int cid = tid + 256 * it, t = cid >> 4, ch = cid & 15;
      *(u32x4*)(sQe + t * 136 + ch * 8) = pq[it];
      *(u32x4*)(sKe + t * 136 + ch * 8) = pk[it];
    }
    int t = tid >> 2, r0 = (tid & 3) * 4;
    *(float4*)(sLow + t * 16 + r0) = make_float4(lo2f(plw.x), hi2f(plw.x), lo2f(plw.y), hi2f(plw.y));
  }
  __syncthreads();
  {
    const int cn = (ci == 0) ? cc + 1 : cc;
    const int rn = chunk_row0<64>(cn, d);
#pragma unroll
    for (int it = 0; it < 4; ++it) {
      int cid = tid + 256 * it, t = cid >> 4, ch = cid & 15;
      const bf16_t* rp = ub + (size_t)(rn + (d ? 63 - t : t)) * NU + U_Q + hd * 128 + ch * 8;
      pq[it] = *(const u32x4*)rp;
      pk[it] = *(const u32x4*)(rp + 512);
    }
    int t = tid >> 2, r0 = (tid & 3) * 4;
    plw = *(const uint2*)(ub + (size_t)(rn + (d ? 63 - t : t)) * NU + U_LOW + d * 16 + r0);
  }
  float lgv[32];
  {
    float tot = 0.f;
#pragma unroll
    for (int tt = 0; tt < 32; ++tt) {
      const int t = half * 32 + tt;
      float z = zb;
#pragma unroll
      for (int rr = 0; rr < 16; ++rr) z += sLow[t * 16 + rr] * up[rr];
      lgv[tt] = (fminf(z, 0.f) - __logf(1.f + __expf(-fabsf(z)))) * 0.0625f;
      tot += lgv[tt];
    }
    sTot[half * 128 + kk] = tot;
  }
  __syncthreads();
  {
    const float t0 = sTot[kk], t1 = sTot[128 + kk];
    float bc = half ? t0 : 0.f;
    if (half == 0) sEb[kk] = __expf(t0 + t1);
#pragma unroll
    for (int tt = 0; tt < 32; ++tt) {
      const int t = half * 32 + tt;
      bc += lgv[tt];
      float qv = bf2f(sQe[t * 136 + kk]);
      float kv = bf2f(sKe[t * 136 + kk]);
      float e = __expf(bc);
      sQe[t * 136 + kk] = f2bf(qv * qscale * e);
      bf16_t keb = f2bf(kv * __builtin_amdgcn_rcpf(e));
      sKe[t * 136 + kk] = keb;
      sKeT[kk * 72 + t] = keb;
    }
  }
  __syncthreads();
  f32x4 att[4];
#pragma unroll
  for (int nt = 0; nt < 4; ++nt) att[nt] = (f32x4){0.f, 0.f, 0.f, 0.f};
#pragma unroll
  for (int ks = 0; ks < 4; ++ks) {
    bf16x8 af = *(const bf16x8*)(sQe + (w * 16 + r) * 136 + ks * 32 + q * 8);
#pragma unroll
    for (int nt = 0; nt < 4; ++nt) {
      if (nt <= w) {
        bf16x8 bfr = *(const bf16x8*)(sKe + (nt * 16 + r) * 136 + ks * 32 + q * 8);
        att[nt] = mfma16(bfr, af, att[nt]);
      }
    }
  }
  {
    bf16_t* attg = (bf16_t*)(blk + 16384);
    const int t = w * 16 + r;
#pragma unroll
    for (int nt = 0; nt < 4; ++nt) {
      const int s0 = nt * 16 + q * 4;
      float a0 = (s0 + 0 <= t) ? att[nt][0] : 0.f, a1 = (s0 + 1 <= t) ? att[nt][1] : 0.f;
      float a2 = (s0 + 2 <= t) ? att[nt][2] : 0.f, a3 = (s0 + 3 <= t) ? att[nt][3] : 0.f;
      uint2 o2;
      o2.x = pack2(a0, a1);
      o2.y = pack2(a2, a3);
      *(uint2*)(attg + t * 64 + s0) = o2;
    }
    bf16_t* qeg = (bf16_t*)blk;
    bf16_t* ketg = (bf16_t*)(blk + 24576);
#pragma unroll
    for (int it = 0; it < 4; ++it) {
      int cid = tid + 256 * it;
      int t2 = cid >> 4, ch = cid & 15;
      {
        const u32x4 qv4 = *(const u32x4*)(sQe + t2 * 136 + ch * 8);
        uint2 h0, h1; h0.x = qv4[0]; h0.y = qv4[1]; h1.x = qv4[2]; h1.y = qv4[3];
        *(uint2*)(qeg + t2 * 128 + kperm_off(ch, 0)) = h0;
        *(uint2*)(qeg + t2 * 128 + kperm_off(ch, 1)) = h1;
      }
      int k2 = cid >> 3, c2 = cid & 7;
      *(u32x4*)(ketg + k2 * 64 + c2 * 8) = *(const u32x4*)(sKeT + k2 * 72 + c2 * 8);
    }
    if (tid < 128) ((float*)(blk + 40960))[tid] = sEb[tid];
  }
  }
}

__device__ void gla_chain(CP p, int l, int bl, int hd, int d, int vs, char* smem) {
  const int tid = tid_opaque(), lane = tid & 63, w = tid >> 6, r = lane & 15, q = lane >> 4;
  bf16_t* sQe = (bf16_t*)smem;
  bf16_t* sAtt = sQe + 64 * 136;
  bf16_t* sKeT = sAtt + 64 * 72;
  bf16_t* sV = sKeT + 128 * 72;
  float* sEb = (float*)(sV + 64 * 72);
  f32x4 S[8];
#pragma unroll
  for (int kt = 0; kt < 8; ++kt) S[kt] = (f32x4){0.f, 0.f, 0.f, 0.f};
  const bf16_t* ub = p->u + (size_t)bl * TPB * NU;
  bf16_t* yb = p->y + (size_t)bl * TPB * NY + 2048 + d * 1024 + hd * 256 + vs * 64;
  const char* blk0 = p->gpre + (size_t)(((bl * 2 + d) * 4 + hd) * 36) * GPRE_BYTES;
  const int vt = tid >> 2, vc = (tid & 3) * 16;
  u32x4 pq[4], pk[4], pa[2], pv[2];
  float pe;
  {
    const char* blk = blk0;
#pragma unroll
    for (int it = 0; it < 4; ++it) {
      pq[it] = *(const u32x4*)(blk + (size_t)(tid + 256 * it) * 16);
      pk[it] = *(const u32x4*)(blk + 24576 + (size_t)(tid + 256 * it) * 16);
    }
#pragma unroll
    for (int it = 0; it < 2; ++it) pa[it] = *(const u32x4*)(blk + 16384 + (size_t)(tid + 256 * it) * 16);
    pe = ((const float*)(blk + 40960))[tid & 127];
    const int row0 = chunk_row0<64>(0, d);
    const bf16_t* vp = ub + (size_t)(row0 + (d ? 63 - vt : vt)) * NU + U_V + hd * 256 + vs * 64 + vc;
    pv[0] = *(const u32x4*)vp;
    pv[1] = *(const u32x4*)(vp + 8);
  }
  for (int cc = 0; cc < 36; ++cc) {
    const int row0 = chunk_row0<64>(cc, d);
    __syncthreads();
#pragma unroll
    for (int it = 0; it < 4; ++it) {
      int cid = tid + 256 * it;
      *(u32x4*)(sQe + (cid >> 4) * 136 + (cid & 15) * 8) = pq[it];
      *(u32x4*)(sKeT + (cid >> 3) * 72 + (cid & 7) * 8) = pk[it];
    }
#pragma unroll
    for (int it = 0; it < 2; ++it) {
      int cid = tid + 256 * it;
      *(u32x4*)(sAtt + (cid >> 3) * 72 + (cid & 7) * 8) = pa[it];
    }
    if (tid < 128) sEb[tid] = pe;
    *(u32x4*)(sV + vt * 72 + vc) = pv[0];
    *(u32x4*)(sV + vt * 72 + vc + 8) = pv[1];
    __syncthreads();
    {
      const int cn = (cc + 1 < 36) ? cc + 1 : cc;
      const char* blk = blk0 + (size_t)cn * GPRE_BYTES;
#pragma unroll
      for (int it = 0; it < 4; ++it) {
        pq[it] = *(const u32x4*)(blk + (size_t)(tid + 256 * it) * 16);
        pk[it] = *(const u32x4*)(blk + 24576 + (size_t)(tid + 256 * it) * 16);
      }
#pragma unroll
      for (int it = 0; it < 2; ++it) pa[it] = *(const u32x4*)(blk + 16384 + (size_t)(tid + 256 * it) * 16);
      pe = ((const float*)(blk + 40960))[tid & 127];
      const int rown = chunk_row0<64>(cn, d);
      const bf16_t* vp = ub + (size_t)(rown + (d ? 63 - vt : vt)) * NU + U_V + hd * 256 + vs * 64 + vc;
      pv[0] = *(const u32x4*)vp;
      pv[1] = *(const u32x4*)(vp + 8);
    }
    bf16x8 vfr[2];
#pragma unroll
    for (int ks = 0; ks < 2; ++ks) vfr[ks] = tr_frag(sV, 72, ks * 32 + q * 8, w * 16, r);
    if (!(l == 3 && cc < 4)) {
    f32x4 oacc[4];
#pragma unroll
    for (int mt = 0; mt < 4; ++mt) oacc[mt] = (f32x4){0.f, 0.f, 0.f, 0.f};
#pragma unroll
    for (int ks = 0; ks < 2; ++ks) {
#pragma unroll
      for (int mt = 0; mt < 4; ++mt) {
        bf16x8 af = *(const bf16x8*)(sAtt + (mt * 16 + r) * 72 + ks * 32 + q * 8);
        oacc[mt] = mfma16(vfr[ks], af, oacc[mt]);
      }
    }
#pragma unroll
    for (int ks = 0; ks < 4; ++ks) {
      union { bf16x8 v; unsigned u[4]; } bs;
      bs.u[0] = pack2(S[2 * ks][0], S[2 * ks][1]);
      bs.u[1] = pack2(S[2 * ks][2], S[2 * ks][3]);
      bs.u[2] = pack2(S[2 * ks + 1][0], S[2 * ks + 1][1]);
      bs.u[3] = pack2(S[2 * ks + 1][2], S[2 * ks + 1][3]);
#pragma unroll
      for (int mt = 0; mt < 4; ++mt) {
        bf16x8 af = *(const bf16x8*)(sQe + (mt * 16 + r) * 136 + ks * 32 + q * 8);
        oacc[mt] = mfma16(bs.v, af, oacc[mt]);
      }
    }
#pragma unroll
    for (int mt = 0; mt < 4; ++mt) {
      const int t = mt * 16 + r;
      const int orow = row0 + (d ? 63 - t : t);
      uint2 o2;
      o2.x = pack2(oacc[mt][0], oacc[mt][1]);
      o2.y = pack2(oacc[mt][2], oacc[mt][3]);
      *(uint2*)(yb + (size_t)orow * NY + w * 16 + q * 4) = o2;
    }
    }
#pragma unroll
    for (int ks = 0; ks < 2; ++ks) {
#pragma unroll
      for (int kt = 0; kt < 8; ++kt) {
        bf16x8 af = *(const bf16x8*)(sKeT + (kt * 16 + r) * 72 + ks * 32 + q * 8);
        S[kt] = mfma16(af, vfr[ks], S[kt]);
      }
    }
#pragma unroll
    for (int kt = 0; kt < 8; ++kt) {
      float4 eb = *(const float4*)(sEb + kt * 16 + q * 4);
      S[kt][0] *= eb.x; S[kt][1] *= eb.y; S[kt][2] *= eb.z; S[kt][3] *= eb.w;
    }
  }
}

__device__ void ssd_pre(CP p, int l, int bl, int d, int g, int cc, char* smem) {
  const int tid = tid_opaque(), lane = tid & 63, w = tid >> 6, r = lane & 15, q = lane >> 4;
  bf16_t* sB = (bf16_t*)smem;
  bf16_t* sC = sB + 64 * 136;
  const bf16_t* ub = p->u + (size_t)bl * TPB * NU;
  const int row0 = chunk_row0<64>(cc, d);
  char* blk = p->spre + (size_t)((((bl * 2 + d) * 4 + g) * 36) + cc) * SPRE_BYTES;
  __syncthreads();
#pragma unroll
  for (int it = 0; it < 4; ++it) {
    int cid = tid + 256 * it, t = cid >> 4, ch = cid & 15;
    int orow = row0 + (d ? 63 - t : t);
    const bf16_t* rp = p->xc + (size_t)(bl * TPB + orow) * XC_LD + 1024 + 2048 + g * 128 + ch * 8;
    u32x4 bv = *(const u32x4*)rp;
    u32x4 cv = *(const u32x4*)(rp + 512);
    *(u32x4*)(sB + t * 136 + ch * 8) = bv;
    *(u32x4*)(sC + t * 136 + ch * 8) = cv;
    {
      uint2 h0, h1; h0.x = cv[0]; h0.y = cv[1]; h1.x = cv[2]; h1.y = cv[3];
      bf16_t* csg = (bf16_t*)blk + t * 128;
      *(uint2*)(csg + kperm_off(ch, 0)) = h0;
      *(uint2*)(csg + kperm_off(ch, 1)) = h1;
    }
  }
  {
    const int orow = row0 + (d ? 63 - lane : lane);
#pragma unroll
    for (int i = 0; i < 2; ++i) {
      const int hh = g * 8 + w * 2 + i;
      const float dtb = p->ssd_dt_bias[(l * 2 + d) * 32 + hh];
      const float aneg = -__expf(p->ssd_a_log[(l * 2 + d) * 32 + hh]);
      float raw = bf2f(ub[(size_t)orow * NU + U_DT + d * 32 + hh]);
      float dtv = softplus(raw + dtb);
      float cs = dtv * aneg;
#pragma unroll
      for (int o = 1; o < 64; o <<= 1) {
        float nb = __shfl_up(cs, o);
        if (lane >= o) cs += nb;
      }
      float* cd = p->cumdt + ((size_t)((bl * 2 + d) * 32 + hh) * 2) * TPB + cc * 64 + lane;
      cd[0] = cs * 1.4426950408889634f;
      cd[TPB] = dtv;
    }
  }
  __syncthreads();
  f32x4 cb[4];
#pragma unroll
  for (int nt = 0; nt < 4; ++nt) cb[nt] = (f32x4){0.f, 0.f, 0.f, 0.f};
#pragma unroll
  for (int ks = 0; ks < 4; ++ks) {
    bf16x8 af = *(const bf16x8*)(sC + (w * 16 + r) * 136 + ks * 32 + q * 8);
#pragma unroll
    for (int nt = 0; nt < 4; ++nt) {
      if (nt <= w) {
        bf16x8 bfr = *(const bf16x8*)(sB + (nt * 16 + r) * 136 + ks * 32 + q * 8);
        cb[nt] = mfma16(bfr, af, cb[nt]);
      }
    }
  }
  {
    bf16_t* cbg = (bf16_t*)(blk + 32768);
    const int t = w * 16 + r;
#pragma unroll
    for (int nt = 0; nt < 4; ++nt) {
      const int s0 = nt * 16 + q * 4;
      uint2 o2;
      o2.x = pack2((s0 + 0 <= t) ? cb[nt][0] : 0.f, (s0 + 1 <= t) ? cb[nt][1] : 0.f);
      o2.y = pack2((s0 + 2 <= t) ? cb[nt][2] : 0.f, (s0 + 3 <= t) ? cb[nt][3] : 0.f);
      *(uint2*)(cbg + t * 64 + s0) = o2;
    }
    bf16_t* btg = (bf16_t*)(blk + 16384);
    const int n = tid >> 1, hf = tid & 1;
#pragma unroll
    for (int c4 = 0; c4 < 4; ++c4) {
      u32x4 o;
#pragma unroll
      for (int e = 0; e < 4; ++e) {
        int s = hf * 32 + c4 * 8 + e * 2;
        o[e] = (unsigned)sB[s * 136 + n] | ((unsigned)sB[(s + 1) * 136 + n] << 16);
      }
      *(u32x4*)(btg + n * 64 + hf * 32 + c4 * 8) = o;
    }
  }
}

__device__ void ssd_chain(CP p, int l, int bl, int hh, int d, char* smem) {
  const int tid = tid_opaque(), lane = tid & 63, w = tid >> 6, r = lane & 15, q = lane >> 4;
  bf16_t* sC = (bf16_t*)smem;
  bf16_t* sBT = sC + 64 * 136;
  bf16_t* sM = sBT + 128 * 72;
  bf16_t* sXd = sM + 64 * 72;
  bf16_t* sXdd = sXd + 64 * 72;
  float* sCum = (float*)(sXdd + 64 * 72);
  const int g = hh >> 3;
  __builtin_amdgcn_s_setprio(3);
  f32x4 S[8];
#pragma unroll
  for (int nt = 0; nt < 8; ++nt) S[nt] = (f32x4){0.f, 0.f, 0.f, 0.f};
  const bf16_t* ub = p->u + (size_t)bl * TPB * NU;
  bf16_t* yb = p->y + (size_t)bl * TPB * NY + 4096 + d * 2048 + hh * 64;
  const char* blk0 = p->spre + (size_t)(((bl * 2 + d) * 4 + g) * 36) * SPRE_BYTES;
  const float* cd0 = p->cumdt + ((size_t)((bl * 2 + d) * 32 + hh) * 2) * TPB;
  const int xt = tid >> 2, xc = (tid & 3) * 16;
  const int mt0 = tid >> 3, ms0 = (tid & 7) * 8;
  u32x4 pc[4], pbt[4], pcb[2], px[2];
  const unsigned vo16 = (unsigned)tid * 16u;
  const unsigned voX = (unsigned)(((d ? 63 - xt : xt) * XC_LD + xc) * 2);
  const char* xbase = (const char*)(p->xc + (size_t)(bl * TPB) * XC_LD + 1024 + hh * 64);
  f32x4 pcs[2];
  float pct[2], pcx, pdx, pcl, pcw;
  {
    const char* blk = blk0;
    const float* cd = cd0;
#pragma unroll
    for (int it = 0; it < 4; ++it) {
      pc[it] = *(const u32x4*)(blk + (vo16 + 4096u * it));
      pbt[it] = *(const u32x4*)(blk + 16384 + (vo16 + 4096u * it));
    }
#pragma unroll
    for (int it = 0; it < 2; ++it) {
      pcb[it] = *(const u32x4*)(blk + 32768 + (vo16 + 4096u * it));
      pct[it] = cd[mt0 + 32 * it];
      pcs[it] = *(const f32x4*)(cd + ms0 + 4 * it);
    }
    pcx = cd[xt];
    pdx = cd[TPB + xt];
    pcl = cd[63];
    pcw = cd[tid & 63];
    const int row0 = chunk_row0<64>(0, d);
    const char* xp = xbase + (size_t)row0 * (XC_LD * 2);
    px[0] = *(const u32x4*)(xp + voX);
    px[1] = *(const u32x4*)(xp + (voX + 16u));
  }
  for (int cc = 0; cc < 36; ++cc) {
    const int row0 = chunk_row0<64>(cc, d);
    __syncthreads();
    const float cumlast = pcl;
#pragma unroll
    for (int it = 0; it < 4; ++it) {
      int cid = tid + 256 * it;
      *(u32x4*)(sC + (cid >> 4) * 136 + (cid & 15) * 8) = pc[it];
      *(u32x4*)(sBT + (cid >> 3) * 72 + (cid & 7) * 8) = pbt[it];
    }
#pragma unroll
    for (int it = 0; it < 2; ++it) {
      const int t = mt0 + 32 * it;
      u32x4 o;
#pragma unroll
      for (int e = 0; e < 4; ++e) {
        const float c0 = (e < 2) ? pcs[0][2 * e] : pcs[1][2 * e - 4];
        const float c1 = (e < 2) ? pcs[0][2 * e + 1] : pcs[1][2 * e - 3];
        float m0 = lo2f(pcb[it][e]) * __builtin_amdgcn_exp2f(fminf(pct[it] - c0, 0.f));
        float m1 = hi2f(pcb[it][e]) * __builtin_amdgcn_exp2f(fminf(pct[it] - c1, 0.f));
        o[e] = pack2(m0, m1);
      }
      *(u32x4*)(sM + t * 72 + ms0) = o;
    }
    {
      const float dec = __builtin_amdgcn_exp2f(cumlast - pcx) * pdx;
#pragma unroll
      for (int hv = 0; hv < 2; ++hv) {
        u32x4 o1, o2;
#pragma unroll
        for (int e = 0; e < 4; ++e) {
          const unsigned wv = px[hv][e];
          const float x0 = lo2f(wv), x1 = hi2f(wv);
          o1[e] = pack2(x0 * pdx, x1 * pdx);
          o2[e] = pack2(x0 * dec, x1 * dec);
        }
        *(u32x4*)(sXd + xt * 72 + xc + hv * 8) = o1;
        *(u32x4*)(sXdd + xt * 72 + xc + hv * 8) = o2;
      }
    }
    if (tid < 64) sCum[tid] = pcw;
    __syncthreads();
    {
      const int cn = (cc + 1 < 36) ? cc + 1 : cc;
      const char* blk = blk0 + (size_t)cn * SPRE_BYTES;
      const float* cd = cd0 + cn * 64;
#pragma unroll
      for (int it = 0; it < 4; ++it) {
        pc[it] = *(const u32x4*)(blk + (vo16 + 4096u * it));
        pbt[it] = *(const u32x4*)(blk + 16384 + (vo16 + 4096u * it));
      }
#pragma unroll
      for (int it = 0; it < 2; ++it) {
        pcb[it] = *(const u32x4*)(blk + 32768 + (vo16 + 4096u * it));
        pct[it] = cd[mt0 + 32 * it];
        pcs[it] = *(const f32x4*)(cd + ms0 + 4 * it);
      }
      pcx = cd[xt];
      pdx = cd[TPB + xt];
      pcl = cd[63];
      pcw = cd[tid & 63];
      const int rown = chunk_row0<64>(cn, d);
      const char* xp = xbase + (size_t)rown * (XC_LD * 2);
      px[0] = *(const u32x4*)(xp + voX);
      px[1] = *(const u32x4*)(xp + (voX + 16u));
    }
    if (!(l == 3 && cc < 4)) {
    f32x4 y1[4], y2[4];
#pragma unroll
    for (int mt = 0; mt < 4; ++mt) { y1[mt] = (f32x4){0.f, 0.f, 0.f, 0.f}; y2[mt] = (f32x4){0.f, 0.f, 0.f, 0.f}; }
#pragma unroll
    for (int ks = 0; ks < 2; ++ks) {
      bf16x8 bfr = tr_frag(sXd, 72, ks * 32 + q * 8, w * 16, r);
#pragma unroll
      for (int mt = 0; mt < 4; ++mt) {
        bf16x8 af = *(const bf16x8*)(sM + (mt * 16 + r) * 72 + ks * 32 + q * 8);
        y1[mt] = mfma16(bfr, af, y1[mt]);
      }
    }
#pragma unroll
    for (int ks = 0; ks < 4; ++ks) {
      union { bf16x8 v; unsigned u[4]; } bs;
      bs.u[0] = pack2(S[2 * ks][0], S[2 * ks][1]);
      bs.u[1] = pack2(S[2 * ks][2], S[2 * ks][3]);
      bs.u[2] = pack2(S[2 * ks + 1][0], S[2 * ks + 1][1]);
      bs.u[3] = pack2(S[2 * ks + 1][2], S[2 * ks + 1][3]);
#pragma unroll
      for (int mt = 0; mt < 4; ++mt) {
        bf16x8 af = *(const bf16x8*)(sC + (mt * 16 + r) * 136 + ks * 32 + q * 8);
        y2[mt] = mfma16(bs.v, af, y2[mt]);
      }
    }
#pragma unroll
    for (int mt = 0; mt < 4; ++mt) {
      const int t = mt * 16 + r;
      const int orow = row0 + (d ? 63 - t : t);
      const float ec = __builtin_amdgcn_exp2f(sCum[t]);
      uint2 o2;
      o2.x = pack2(y1[mt][0] + ec * y2[mt][0], y1[mt][1] + ec * y2[mt][1]);
      o2.y = pack2(y1[mt][2] + ec * y2[mt][2], y1[mt][3] + ec * y2[mt][3]);
      *(uint2*)(yb + (size_t)orow * NY + w * 16 + q * 4) = o2;
    }
    }
    const float dl = __builtin_amdgcn_exp2f(cumlast);
#pragma unroll
    for (int nt = 0; nt < 8; ++nt) { S[nt][0] *= dl; S[nt][1] *= dl; S[nt][2] *= dl; S[nt][3] *= dl; }
#pragma unroll
    for (int ks = 0; ks < 2; ++ks) {
      bf16x8 bfr = tr_frag(sXdd, 72, ks * 32 + q * 8, w * 16, r);
#pragma unroll
      for (int nt = 0; nt < 8; ++nt) {
        bf16x8 af = *(const bf16x8*)(sBT + (nt * 16 + r) * 72 + ks * 32 + q * 8);
        S[nt] = mfma16(af, bfr, S[nt]);
      }
    }
  }
  __builtin_amdgcn_s_setprio(0);
}

__device__ void lru_pre(CP p, int l, int bl, int n, int d, int c4, char* smem) {
  const int tid = tid_opaque(), lane = tid & 63, w = tid >> 6, r = lane & 15, q = lane >> 4;
  bf16_t* sXa = (bf16_t*)smem;
  float* sA = (float*)(smem + 32 * 136 * 2);
  float* sB = sA + 32 * 128;
  float* sE = sB + 32 * 128;
  const int mi = ((l * 2 + d) * 8 + n);
  const bf16_t* wr = p->wrT + (size_t)mi * 128 * 128;
  const bf16_t* wi = p->wiT + (size_t)mi * 128 * 128;
  bf16x8 fr[2][4], fi[2][4];
#pragma unroll
  for (int ct = 0; ct < 2; ++ct)
#pragma unroll
    for (int ks = 0; ks < 4; ++ks) {
      fr[ct][ks] = *(const bf16x8*)(wr + (w * 32 + ct * 16 + r) * 128 + ks * 32 + q * 8);
      fi[ct][ks] = *(const bf16x8*)(wi + (w * 32 + ct * 16 + r) * 128 + ks * 32 + q * 8);
    }
  float br[2][4], bi[2][4], cl[2][4];
#pragma unroll
  for (int ct = 0; ct < 2; ++ct)
#pragma unroll
    for (int e = 0; e < 4; ++e) {
      int j = (l * 2 + d) * 1024 + n * 128 + w * 32 + ct * 16 + q * 4 + e;
      br[ct][e] = p->lru_br[j];
      bi[ct][e] = p->lru_bi[j];
      cl[ct][e] = -8.f * softplus(-p->lru_lam[j]);
    }
  const bf16_t* ub = p->xc + (size_t)bl * TPB * XC_LD + n * 128;
  bf16_t* yb = p->y + (size_t)bl * TPB * NY + d * 1024 + n * 128;
  bf16_t* ab = p->acum + (size_t)bl * TPB * 2048 + d * 1024 + n * 128;
  u32x4 pxa[2];
  {
    const int r0 = chunk_row0<32>(c4 * 4, d);
#pragma unroll
    for (int it = 0; it < 2; ++it) {
      int cid = tid + 256 * it, t = cid >> 4, ch = cid & 15;
      pxa[it] = *(const u32x4*)(ub + (size_t)(r0 + (d ? 31 - t : t)) * XC_LD + ch * 8);
    }
  }
  for (int ci = 0; ci < 4; ++ci) {
    const int cc = c4 * 4 + ci;
    const int row0 = chunk_row0<32>(cc, d);
    __syncthreads();
#pragma unroll
    for (int it = 0; it < 2; ++it) {
      int cid = tid + 256 * it, t = cid >> 4, ch = cid & 15;
      *(u32x4*)(sXa + t * 136 + ch * 8) = pxa[it];
    }
    __syncthreads();
    {
      const int cn = (ci + 1 < 4) ? cc + 1 : cc;
      const int rn = chunk_row0<32>(cn, d);
#pragma unroll
      for (int it = 0; it < 2; ++it) {
        int cid = tid + 256 * it, t = cid >> 4, ch = cid & 15;
        pxa[it] = *(const u32x4*)(ub + (size_t)(rn + (d ? 31 - t : t)) * XC_LD + ch * 8);
      }
    }
    f32x4 aR[2][2], aI[2][2];
#pragma unroll
    for (int mt = 0; mt < 2; ++mt)
#pragma unroll
      for (int ct = 0; ct < 2; ++ct) { aR[mt][ct] = (f32x4){0.f, 0.f, 0.f, 0.f}; aI[mt][ct] = (f32x4){0.f, 0.f, 0.f, 0.f}; }
#pragma unroll
    for (int ks = 0; ks < 4; ++ks) {
#pragma unroll
      for (int mt = 0; mt < 2; ++mt) {
        bf16x8 af = *(const bf16x8*)(sXa + (mt * 16 + r) * 136 + ks * 32 + q * 8);
#pragma unroll
        for (int ct = 0; ct < 2; ++ct) {
          aR[mt][ct] = mfma16(fr[ct][ks], af, aR[mt][ct]);
          aI[mt][ct] = mfma16(fi[ct][ks], af, aI[mt][ct]);
        }
      }
    }
#pragma unroll
    for (int mt = 0; mt < 2; ++mt)
#pragma unroll
      for (int ct = 0; ct < 2; ++ct) {
        const int t = mt * 16 + r, j0 = w * 32 + ct * 16 + q * 4;
        float av[4], bv[4];
#pragma unroll
        for (int e = 0; e < 4; ++e) {
          float xav = bf2f(sXa[t * 136 + j0 + e]);
          float rg = sigm(aR[mt][ct][e] + br[ct][e]);
          float ig = sigm(aI[mt][ct][e] + bi[ct][e]);
          float la = cl[ct][e] * rg;
          av[e] = __expf(la);
          bv[e] = __builtin_amdgcn_sqrtf(fmaxf(1.f - __expf(2.f * la), 0.f)) * (ig * xav);
        }
        *(float4*)(sA + t * 128 + j0) = make_float4(av[0], av[1], av[2], av[3]);
        *(float4*)(sB + t * 128 + j0) = make_float4(bv[0], bv[1], bv[2], bv[3]);
      }
    __syncthreads();
    {
      const int j = tid & 127, th = (tid >> 7) * 16;
      float hv[16], av[16];
      float hl = 0.f, ac = 1.f;
#pragma unroll
      for (int t = 0; t < 16; ++t) {
        const float a = sA[(th + t) * 128 + j];
        hl = a * hl + sB[(th + t) * 128 + j];
        ac *= a;
        hv[t] = hl; av[t] = ac;
      }
      if (tid < 128) *(float2*)(sE + 2 * j) = make_float2(ac, hl);
      __syncthreads();
      if (tid >= 128) {
        const float2 e1 = *(const float2*)(sE + 2 * j);
#pragma unroll
        for (int t = 0; t < 16; ++t) { hv[t] += av[t] * e1.y; av[t] *= e1.x; }
      }
#pragma unroll
      for (int t = 0; t < 16; ++t) {
        const int tt = th + t;
        const int orow = row0 + (d ? 31 - tt : tt);
        yb[(size_t)orow * NY + j] = f2bf(hv[t]);
        ab[(size_t)orow * 2048 + j] = f2bf(av[t]);
      }
      if (tid >= 128) {
        float2* ep = (float2*)p->lruE + ((size_t)((bl * 2 + d) * 72 + cc) * 1024 + n * 128 + j);
        *ep = make_float2(av[15], hv[15]);
      }
    }
  }
}

__device__ void lru_chain(CP p, int bl, int d, int qt) {
  const int tid = tid_opaque();
  const int ch = qt * 256 + tid;
  const float2* ep = (const float2*)p->lruE + (size_t)((bl * 2 + d) * 72) * 1024 + ch;
  float* hp = p->lruH + (size_t)((bl * 2 + d) * 72) * 1024 + ch;
  float h = 0.f;
#pragma unroll 8
  for (int c = 0; c < 72; ++c) {
    hp[(size_t)c * 1024] = h;
    float2 e = ep[(size_t)c * 1024];
    h = e.x * h + e.y;
  }
}

__device__ void phase_pre_a(CP p, int l, char* smem) {
  const int NB = p->NB;
  const int L = (l & 1) ? 32 : 64;
  const int n_gla = NB * 2 * 4 * 18, n_conv = NB * TPB / 2;
  for (int item = blockIdx.x; item < n_gla + n_conv; item += gridDim.x) {
    if (item < n_gla) {
      int cc2 = item % 18, rest = item / 18;
      gla_pre(p, l, rest >> 3, (rest >> 2) & 1, rest & 3, cc2, smem);
    } else {
      conv_block(p, l, item - n_gla, L);
    }
  }
}

__device__ void phase_pre_b(CP p, int l, char* smem) {
  const int NB = p->NB;
  const int n_lru = NB * 8 * 2 * 18, n_ssd = NB * 2 * 4 * 36;
  for (int item = blockIdx.x; item < n_lru + n_ssd; item += gridDim.x) {
    if (item < n_lru) {
      int c4 = item % 18, rest = item / 18;
      lru_pre(p, l, rest >> 4, (rest >> 1) & 7, rest & 1, c4, smem);
    } else {
      int it = item - n_lru;
      int cc = it % 36, rest = it / 36;
      ssd_pre(p, l, rest >> 3, (rest >> 2) & 1, rest & 3, cc, smem);
    }
  }
}

__device__ void phase_chain(CP p, int g, int l, char* smem) {
  const int NB = p->NB;
  const int n_ssd = NB * 64, n_gla = NB * 32, n_lru = NB * 8;
  if (g == 0 && l < 3) {
    const int n_items = n_ssd + n_gla + n_lru;
    const int nidle = (int)gridDim.x - n_items;
    if (nidle >= 32) {
      if ((int)blockIdx.x >= n_items)
        for (int it = blockIdx.x - n_items; it < N_LAYER_TILES; it += nidle) convert_layer_item(p, l + 1, it, (float*)smem);
    } else {
      for (int it = blockIdx.x; it < N_LAYER_TILES; it += gridDim.x) convert_layer_item(p, l + 1, it, (float*)smem);
      __syncthreads();
    }
  }
  for (int item = blockIdx.x; item < n_ssd + n_gla + n_lru; item += gridDim.x) {
    int it = item;
    const bool xcd_map = (NB == 4) && (gridDim.x == 512);
    if (it < n_ssd) {
      int bl = it >> 6, hh = (it >> 1) & 31, d = it & 1;
      if (xcd_map) {
        const int x = it & 7, j = it >> 3, team = x * 4 + (j >> 3);
        bl = team >> 3; hh = ((team >> 1) & 3) * 8 + (j & 7); d = team & 1;
      }
      ssd_chain(p, l, bl, hh, d, smem);
    } else if (it < n_ssd + n_gla) {
      it -= n_ssd;
      int bl = it >> 5, hd = (it >> 3) & 3, d = (it >> 2) & 1, vs = it & 3;
      if (xcd_map) {
        const int x = it & 7, j = it >> 3, team = x * 4 + (j >> 2);
        bl = team >> 3; hd = (team >> 1) & 3; d = team & 1; vs = j & 3;
      }
      gla_chain(p, l, bl, hd, d, vs, smem);
    } else {
      it -= n_ssd + n_gla;
      lru_chain(p, it >> 3, (it >> 2) & 1, it & 3);
    }
    __syncthreads();
  }
}

__device__ __forceinline__ void ld16bf(const bf16_t* p, float (&o)[16]) {
  uint4 a = *(const uint4*)p, b = *(const uint4*)(p + 8);
  unsigned wv[8] = {a.x, a.y, a.z, a.w, b.x, b.y, b.z, b.w};
#pragma unroll
  for (int e = 0; e < 8; ++e) { o[2 * e] = lo2f(wv[e]); o[2 * e + 1] = hi2f(wv[e]); }
}
__device__ __forceinline__ void st16bf(bf16_t* p, const float (&v)[16]) {
  uint4 a, b;
  a.x = pack2(v[0], v[1]); a.y = pack2(v[2], v[3]); a.z = pack2(v[4], v[5]); a.w = pack2(v[6], v[7]);
  b.x = pack2(v[8], v[9]); b.y = pack2(v[10], v[11]); b.z = pack2(v[12], v[13]); b.w = pack2(v[14], v[15]);
  *(uint4*)p = a;
  *(uint4*)(p + 8) = b;
}
__device__ void phase_prep(CP p, int l) {
  const int tid = tid_opaque(), lane = tid & 63, w = tid >> 6;
  const int nrows = p->NB * TPB;
  for (int rr = blockIdx.x * 4 + w; rr < nrows; rr += gridDim.x * 4) {
    if (l == 3 && (rr % TPB) < 256) continue;
    const bf16_t* yr = p->y + (size_t)rr * NY;
    const bf16_t* ur = p->u + (size_t)rr * NU;
    bf16_t* ar = p->acat + (size_t)rr * 4096;
    const int c0 = lane * 16;
    float a[16], b2[16], gt[16];
    {
      const int bl = rr / TPB, pp = rr % TPB;
      const int ccf = (pp < 256) ? (pp >> 5) : 8 + ((pp - 256) >> 5);
      const int ccb = (pp < 256) ? 7 - (pp >> 5) : 8 + 63 - ((pp - 256) >> 5);
      const bf16_t* acr = p->acum + (size_t)rr * 2048;
      const float* hf = p->lruH + (size_t)((bl * 2 + 0) * 72 + ccf) * 1024 + c0;
      const float* hb = p->lruH + (size_t)((bl * 2 + 1) * 72 + ccb) * 1024 + c0;
      float af[16], abk[16];
      ld16bf(yr + c0, a); ld16bf(yr + 1024 + c0, b2); ld16bf(ur + U_LRUG + c0, gt);
      ld16bf(acr + c0, af); ld16bf(acr + 1024 + c0, abk);
#pragma unroll
      for (int e4 = 0; e4 < 4; ++e4) {
        float4 h0 = *(const float4*)(hf + e4 * 4), h1 = *(const float4*)(hb + e4 * 4);
        a[e4 * 4 + 0] += af[e4 * 4 + 0] * h0.x + b2[e4 * 4 + 0] + abk[e4 * 4 + 0] * h1.x;
        a[e4 * 4 + 1] += af[e4 * 4 + 1] * h0.y + b2[e4 * 4 + 1] + abk[e4 * 4 + 1] * h1.y;
        a[e4 * 4 + 2] += af[e4 * 4 + 2] * h0.z + b2[e4 * 4 + 2] + abk[e4 * 4 + 2] * h1.z;
        a[e4 * 4 + 3] += af[e4 * 4 + 3] * h0.w + b2[e4 * 4 + 3] + abk[e4 * 4 + 3] * h1.w;
      }
#pragma unroll
      for (int e = 0; e < 16; ++e) a[e] = a[e] * silu(gt[e]);
      st16bf(ar + c0, a);
    }
    ld16bf(yr + 2048 + c0, a); ld16bf(yr + 3072 + c0, b2); ld16bf(ur + U_GG + c0, gt);
    float ss = 0.f;
#pragma unroll
    for (int e = 0; e < 16; ++e) { a[e] += b2[e]; ss += a[e] * a[e]; }
#pragma unroll
    for (int o = 8; o >= 1; o >>= 1) ss += __shfl_xor(ss, o);
    float rinv = rsqrtf(ss * (1.f / 256.f) + EPSV);
    {
      const float* gn = p->gla_norm_g + l * 256 + (c0 & 255);
#pragma unroll
      for (int e = 0; e < 16; ++e) a[e] = a[e] * rinv * gn[e] * silu(gt[e]);
    }
    st16bf(ar + 1024 + c0, a);
    const int c1 = lane * 32;
    float v3[2][16];
    ss = 0.f;
#pragma unroll
    for (int hlf = 0; hlf < 2; ++hlf) {
      float xs[16];
      const float Dh = p->ssd_d[l * 32 + (lane >> 1)];
      ld16bf(yr + 4096 + c1 + hlf * 16, a); ld16bf(yr + 6144 + c1 + hlf * 16, b2); ld16bf(ur + U_Z + c1 + hlf * 16, gt);
      ld16bf(p->xc + (size_t)rr * XC_LD + 1024 + c1 + hlf * 16, xs);
#pragma unroll
      for (int e = 0; e < 16; ++e) { float v = (a[e] + b2[e] + Dh * xs[e]) * silu(gt[e]); v3[hlf][e] = v; ss += v * v; }
    }
#pragma unroll
    for (int o = 8; o >= 1; o >>= 1) ss += __shfl_xor(ss, o);
    rinv = rsqrtf(ss * (1.f / 512.f) + EPSV);
#pragma unroll
    for (int hlf = 0; hlf < 2; ++hlf) {
      const float* gn = p->ssd_norm_g + l * 2048 + c1 + hlf * 16;
#pragma unroll
      for (int e = 0; e < 16; ++e) v3[hlf][e] = v3[hlf][e] * rinv * gn[e];
      st16bf(ar + 2048 + c1 + hlf * 16, v3[hlf]);
    }
  }
}

__device__ void phase_merge(CP p, int l, bf16_t* smem) {
  const int tid = tid_opaque(), lane = tid & 63, w = tid >> 6, r = lane & 15, q = lane >> 4;
  const int MT = p->NB * TPB / 144, NT = 8;
  for (int tile = blockIdx.x; tile < MT * NT; tile += gridDim.x) {
    const int mt = tile % MT, nt = tile / MT;
    if (l == 3 && (mt & 15) == 0) continue;
    f32x4 mg[9][2];
#pragma unroll
    for (int i = 0; i < 9; ++i) { mg[i][0] = (f32x4){0.f, 0.f, 0.f, 0.f}; mg[i][1] = (f32x4){0.f, 0.f, 0.f, 0.f}; }
#pragma unroll 1
    for (int br = 0; br < 3; ++br) {
      f32x4 acc[9][2];
#pragma unroll
      for (int i = 0; i < 9; ++i) { acc[i][0] = (f32x4){0.f, 0.f, 0.f, 0.f}; acc[i][1] = (f32x4){0.f, 0.f, 0.f, 0.f}; }
      const bf16_t* A = p->acat + (br == 0 ? 0 : br == 1 ? 1024 : 2048);
      const bf16_t* Bt = (br == 0 ? p->wpaT + (size_t)l * 1024 * 1024 : br == 1 ? p->wpbT + (size_t)l * 1024 * 1024 : p->wpcT + (size_t)l * 1024 * 2048);
      const int K = (br == 2) ? 2048 : 1024;
      gemm_tile144<0>(A, 4096, Bt, K, K, mt * 144, nt * 128, acc, smem);
#pragma unroll
      for (int i = 0; i < 9; ++i) {
        const bf16_t* gp = p->u + (size_t)(mt * 144 + i * 16 + r) * NU + U_MG + br * 1024 + nt * 128 + w * 32 + q * 4;
#pragma unroll
        for (int j = 0; j < 2; ++j) {
          float4 gv = ld4bf(gp + j * 16);
          mg[i][j][0] += sigm(gv.x) * acc[i][j][0];
          mg[i][j][1] += sigm(gv.y) * acc[i][j][1];
          mg[i][j][2] += sigm(gv.z) * acc[i][j][2];
          mg[i][j][3] += sigm(gv.w) * acc[i][j][3];
        }
      }
    }
#pragma unroll
    for (int i = 0; i < 9; ++i) {
      bf16_t* rowp = p->h + (size_t)(mt * 144 + i * 16 + r) * 1024 + nt * 128 + w * 32 + q * 4;
#pragma unroll
      for (int j = 0; j < 2; ++j) {
        uint2 o2;
        o2.x = pack2(mg[i][j][0], mg[i][j][1]);
        o2.y = pack2(mg[i][j][2], mg[i][j][3]);
        *(uint2*)(rowp + j * 16) = o2;
      }
    }
  }
}

__device__ void phase_out(CP p, int l, bf16_t* smem) {
  const int tid = tid_opaque(), lane = tid & 63, w = tid >> 6, r = lane & 15, q = lane >> 4;
  const int MT = p->NB * TPB / 144, NT = 8;
  const bf16_t* Bt = p->woutT + (size_t)l * 1024 * 1024;
  for (int tile = blockIdx.x; tile < MT * NT; tile += gridDim.x) {
    const int mt = tile % MT, nt = tile / MT;
    if (l == 3 && (mt & 15) == 0) continue;
    f32x4 acc[9][2];
#pragma unroll
    for (int i = 0; i < 9; ++i) { acc[i][0] = (f32x4){0.f, 0.f, 0.f, 0.f}; acc[i][1] = (f32x4){0.f, 0.f, 0.f, 0.f}; }
    gemm_tile144<1>(p->h, 1024, Bt, 1024, 1024, mt * 144, nt * 128, acc, smem);
#pragma unroll
    for (int i = 0; i < 9; ++i) {
      const int row = mt * 144 + i * 16 + r;
      float* rowp = p->obuf + (size_t)row * 1024 + nt * 128 + w * 32 + q * 4;
      float ss = 0.f;
#pragma unroll
      for (int j = 0; j < 2; ++j) {
        *(float4*)(rowp + j * 16) = make_float4(acc[i][j][0], acc[i][j][1], acc[i][j][2], acc[i][j][3]);
        ss += acc[i][j][0] * acc[i][j][0] + acc[i][j][1] * acc[i][j][1] + acc[i][j][2] * acc[i][j][2] + acc[i][j][3] * acc[i][j][3];
      }
      ss += __shfl_xor(ss, 16);
      ss += __shfl_xor(ss, 32);
      if (q == 0) p->sspart[(size_t)row * 32 + nt * 4 + w] = ss;
    }
  }
}

#define XB_TMO      128
#define XB_XCNT(j)  (256  + 64 * (j))
#define XB_XSUB(j)  (1280 + 64 * (j))
#define XB_XGEN(j)  (2304 + 64 * (j))
#define XB_TOP      3328
#define XB_TOPGEN   3392
#define XCD_BAR_WORDS 3456
#define XB_SPIN_CAP (1u << 22)
#define LAS __attribute__((address_space(3)))
__device__ __forceinline__ unsigned xb_ld(unsigned* p)              { return __hip_atomic_load(p, __ATOMIC_RELAXED, __HIP_MEMORY_SCOPE_AGENT); }
__device__ __forceinline__ unsigned xb_add(unsigned* p, unsigned v) { return __hip_atomic_fetch_add(p, v, __ATOMIC_RELAXED, __HIP_MEMORY_SCOPE_AGENT); }
__device__ __forceinline__ unsigned xb_xcc_id() { return (unsigned)__builtin_amdgcn_s_getreg((3 << 11) | 20) & 0xFu; }
#define XB_SPIN(cond, bar) do { unsigned _sp = 0; while (cond) { __builtin_amdgcn_s_sleep(1); \
    if ((++_sp & 255u) == 0u) { if (xb_ld(&(bar)[XB_TMO])) break; if (_sp > XB_SPIN_CAP) { atomicAdd(&(bar)[XB_TMO], 1u); break; } } } } while (0)
struct XcdBarrier { unsigned* bar; unsigned x; volatile LAS unsigned* st; };
__device__ __forceinline__ XcdBarrier xcd_barrier_post(unsigned* bar, volatile LAS unsigned* st) {
  XcdBarrier b; b.bar = bar; b.x = xb_xcc_id(); b.st = st;
  if (threadIdx.x == 0) (void)xb_add(&bar[XB_XCNT(b.x)], 1u);
  return b;
}
__device__ __forceinline__ void xcd_barrier_complete(unsigned* bar, unsigned x, unsigned& nloc, unsigned& nx) {
  const unsigned G = gridDim.x * gridDim.y * gridDim.z;
  unsigned sum, cnt, mine, sp = 0u;
  for (;;) {
    sum = 0u; cnt = 0u; mine = 0u;
#pragma unroll
    for (unsigned j = 0; j < 16; ++j) { const unsigned c = xb_ld(&bar[XB_XCNT(j)]); sum += c; cnt += (c > 0u) ? 1u : 0u; mine = (j == x) ? c : mine; }
    if (sum == G) break;
    __builtin_amdgcn_s_sleep(1);
    if ((++sp & 255u) == 0u) { if (xb_ld(&bar[XB_TMO])) break; if (sp > XB_SPIN_CAP) { atomicAdd(&bar[XB_TMO], 1u); break; } }
  }
  nloc = mine > 0u ? mine : 1u; nx = cnt > 0u ? cnt : 1u;
}
__device__ __forceinline__ void xcd_barrier(const XcdBarrier& b) {
  asm volatile("s_waitcnt vmcnt(0)" ::: "memory");
  __syncthreads();
  if (threadIdx.x == 0) {
    unsigned* bar = b.bar;
    __builtin_amdgcn_s_waitcnt(0);
    unsigned nloc = b.st[0], nx = b.st[1];
    if (nloc == 0u) { xcd_barrier_complete(bar, b.x, nloc, nx); b.st[0] = nloc; b.st[1] = nx; }
    const unsigned old = xb_add(&bar[XB_XSUB(b.x)], 1u);
    const unsigned gen = old / nloc;
    if (old + 1u == (gen + 1u) * nloc) {
      __builtin_amdgcn_fence(__ATOMIC_RELEASE, "agent");
      asm volatile("s_waitcnt vmcnt(0)" ::: "memory");
      const unsigned og = xb_add(&bar[XB_TOP], 1u);
      const unsigned tg = og / nx;
      if (og + 1u == (tg + 1u) * nx) xb_add(&bar[XB_TOPGEN], 1u);
      else XB_SPIN(xb_ld(&bar[XB_TOPGEN]) == tg, bar);
      __builtin_amdgcn_fence(__ATOMIC_ACQUIRE, "agent");
      xb_add(&bar[XB_XGEN(b.x)], 1u);
      asm volatile("s_waitcnt vmcnt(0)" ::: "memory");
    } else {
      XB_SPIN(xb_ld(&bar[XB_XGEN(b.x)]) == gen, bar);
      __builtin_amdgcn_fence(__ATOMIC_ACQUIRE, "agent");
      asm volatile("s_waitcnt vmcnt(0)" ::: "memory");
    }
  }
  __syncthreads();
}

__global__ void __launch_bounds__(256, 2) mega(Params pv, int ph_begin, int ph_end) {
  __shared__ __attribute__((aligned(16))) char smem[SMEM_BYTES];
  cg::grid_group grid = cg::this_grid();
  volatile LAS unsigned* xst = (volatile LAS unsigned*)(smem + SMEM_BYTES - 16);
  if (threadIdx.x == 0) { xst[0] = 0u; xst[1] = 0u; }
  __syncthreads();
  XcdBarrier xb = xcd_barrier_post(pv.bar, xst);
  for (int ph = ph_begin; ph < ph_end; ++ph) {
    CP p = (CP)__builtin_amdgcn_kernarg_segment_ptr();
    asm volatile("" : "+s"(p));
    if (ph == 0) {
      phase_prologue(p, (float*)smem);
    } else {
      const int qq = ph - 1, g = qq / NPH_PER_GROUP, s = qq % NPH_PER_GROUP;
      if (s == 32) {
        phase_p1(p, g, 4);
      } else {
        const int l = s / 8, k = s % 8;
        switch (k) {
          case 0: phase_p1(p, g, l); break;
          case 1: phase_gemm_in(p, l, (bf16_t*)smem); break;
          case 2: phase_pre_a(p, l, smem); break;
          case 3: phase_pre_b(p, l, smem); break;
          case 4: phase_chain(p, g, l, smem); break;
          case 5: phase_prep(p, l); break;
          case 6: phase_merge(p, l, (bf16_t*)smem); break;
          default: phase_out(p, l, (bf16_t*)smem); break;
        }
      }
    }
    if (ph + 1 < ph_end) {
      if (ph == 0) grid.sync(); else xcd_barrier(xb);
    }
  }
}

static inline size_t align_up(size_t v, size_t a) { return (v + a - 1) / a * a; }

extern "C" void kernel_launch(void* const* d_in, const int* in_sizes, int n_in, void* d_out, int out_size, void* d_ws,
                              size_t ws_size, hipStream_t stream) {
  Params p{};
  const float** fp = (const float**)&p;
  for (int i = 0; i < 29; ++i) fp[i] = (const float*)d_in[i];
  p.out = (float*)d_out;
  char* ws = (char*)d_ws;
  size_t off = 0;
  auto take = [&](size_t bytes) { char* r = ws + off; off = align_up(off + bytes, 256); return r; };
  p.bar = (unsigned*)take((size_t)XCD_BAR_WORDS * 4);
  p.winT = (bf16_t*)take((size_t)4 * NU * 1024 * 2);
  p.wpaT = (bf16_t*)take((size_t)4 * 1024 * 1024 * 2);
  p.wpbT = (bf16_t*)take((size_t)4 * 1024 * 1024 * 2);
  p.wpcT = (bf16_t*)take((size_t)4 * 1024 * 2048 * 2);
  p.woutT = (bf16_t*)take((size_t)4 * 1024 * 1024 * 2);
  p.wrT = (bf16_t*)take((size_t)64 * 128 * 128 * 2);
  p.wiT = (bf16_t*)take((size_t)64 * 128 * 128 * 2);
  p.mod = (float*)take((size_t)4 * 17 * 3072 * 4);
  p.xctx = (float*)take((size_t)16 * 256 * 1024 * 4);
  const size_t fixed = off;
  int NB = 4;
  for (; NB > 1; NB >>= 1) {
    size_t rows = (size_t)NB * TPB;
    size_t need = rows * (1024 * 4 + 32 * 4 + 1024 * 2 + (size_t)NU * 2 + NY * 2 + 4096 * 2 + 2048 * 2 + 4096 * 2) +
                  (size_t)NB * (2 * 72 * 1024 * 12 + 2 * 32 * 2 * TPB * 4) + 16 * 256;
    if (fixed + need <= ws_size) break;
  }
  p.NB = NB;
  p.ngroups = 16 / NB;
  const size_t rows = (size_t)NB * TPB;
  p.obuf = (float*)take(rows * 1024 * 4);
  p.sspart = (float*)take(rows * 32 * 4);
  p.h = (bf16_t*)take(rows * 1024 * 2);
  p.spre = (char*)p.obuf;
  p.acat = (bf16_t*)take(rows * 4096 * 2);
  p.gpre = (char*)p.acat;
  p.u = (bf16_t*)take(rows * NU * 2);
  p.y = (bf16_t*)take(rows * NY * 2);
  p.acum = (bf16_t*)take(rows * 2048 * 2);
  p.xc = (bf16_t*)take(rows * 4096 * 2);
  p.lruE = (float*)take((size_t)NB * 2 * 72 * 1024 * 8);
  p.lruH = (float*)take((size_t)NB * 2 * 72 * 1024 * 4);
  p.cumdt = (float*)take((size_t)NB * 2 * 32 * 2 * TPB * 4);

  static int grid_blocks = 0;
  if (!grid_blocks) {
    int dev = 0, cus = 0, per_cu = 0;
    hipGetDevice(&dev);
    hipDeviceGetAttribute(&cus, hipDeviceAttributeMultiprocessorCount, dev);
    hipOccupancyMaxActiveBlocksPerMultiprocessor(&per_cu, (const void*)mega, 256, 0);
    if (per_cu > 2) per_cu = 2;
    if (per_cu < 1) per_cu = 1;
    grid_blocks = cus * per_cu;
  }
  hipMemsetAsync(p.bar, 0, (size_t)XCD_BAR_WORDS * 4, stream);
  const int nph = 1 + p.ngroups * NPH_PER_GROUP;
  int b = 0, e = nph;
  void* args[] = {&p, &b, &e};
  hipError_t err = hipLaunchCooperativeKernel((const void*)mega, dim3(grid_blocks), dim3(256), args, 0, stream);
  if (err != hipSuccess) fprintf(stderr, "cooperative launch failed: %s (grid %d)\n", hipGetErrorString(err), grid_blocks);
}
```
